# Optimizing an MI355X kernel written in HIP

```python
import math
import jax, jax.numpy as jnp
from jax import lax
import numpy as np

D_MODEL = 1024
BATCH = 8
SEQ = 2048
DEPTH = 2

D_MIX = D_MODEL
DN_HEADS = 4
DN_DK = 128
DN_DV = 128
DN_CONV = 4
DN_CHUNK = 64
DN_WIDTH = DN_HEADS * DN_DV
DN_KEY_WIDTH = DN_HEADS * DN_DK
GLA_HEADS = 4
GLA_DK = 64
GLA_DV = 128
GLA_GATE_RANK = 16
GLA_TAU = 16.0
GLA_CHUNK = 16
GLA_WIDTH = GLA_HEADS * GLA_DV
GLA_KEY_WIDTH = GLA_HEADS * GLA_DK
IN_SIZES = (DN_KEY_WIDTH, DN_KEY_WIDTH, DN_WIDTH,
            DN_WIDTH,
            DN_HEADS, DN_HEADS,
            GLA_KEY_WIDTH, GLA_KEY_WIDTH, GLA_WIDTH,
            GLA_WIDTH,
            GLA_GATE_RANK)
D_IN_PROJ = 3 * 512 + 512 + 4 + 4 + 256 + 256 + 512 + 512 + 16
DEEPNORM_ALPHA = (2.0 * DEPTH) ** 0.25
DEEPNORM_BETA = (8.0 * DEPTH) ** -0.25
NORM_EPS = 1e-6

kernel_name = "hymba_style_gdn_gla_deepnorm"


def _split(a, sizes):
    out, off = [], 0
    for s in sizes:
        out.append(a[..., off:off + s])
        off += s
    return out


def _to_chunks(a, chunk):
    b, t = a.shape[:2]
    a = a.reshape((b, t // chunk, chunk) + a.shape[2:])
    return jnp.moveaxis(a, 3, 1)


def _from_scan(o):
    n, b, h, c, d = o.shape
    return jnp.transpose(o, (1, 0, 3, 2, 4)).reshape(b, n * c, h, d)


def causal_short_conv(x, w):
    k, c = w.shape
    return lax.conv_general_dilated(
        x, w[:, None, :].astype(x.dtype), window_strides=(1,),
        padding=[(k - 1, 0)], dimension_numbers=("NWC", "WIO", "NWC"),
        feature_group_count=c)


def l2norm(x):
    xf = x.astype(jnp.float32)
    return xf * lax.rsqrt(jnp.sum(xf * xf, axis=-1, keepdims=True) + NORM_EPS)


def head_rms_norm(o, g):
    of = o.astype(jnp.float32)
    of = of * lax.rsqrt(jnp.mean(of * of, axis=-1, keepdims=True) + NORM_EPS)
    return of * g.astype(jnp.float32)


def layer_norm(x, g, b):
    xf = x.astype(jnp.float32)
    mu = jnp.mean(xf, axis=-1, keepdims=True)
    var = jnp.mean(jnp.square(xf - mu), axis=-1, keepdims=True)
    y = (xf - mu) * lax.rsqrt(var + NORM_EPS) * g.astype(jnp.float32) + b.astype(jnp.float32)
    return y.astype(x.dtype)


def gated_delta_rule_chunked(q, k, v, g, beta):
    f32 = jnp.float32
    q, k, v, g, beta = (a.astype(f32) for a in (q, k, v, g, beta))
    b_, t, h, dk = q.shape
    dv = v.shape[-1]
    c = DN_CHUNK
    qc, kc, vc = (_to_chunks(a, c) for a in (q, k, v))
    gc, bc = _to_chunks(g, c), _to_chunks(beta, c)
    G = jnp.cumsum(gc, axis=-1)
    pos = jnp.arange(c)
    causal = pos[:, None] >= pos[None, :]
    strict = pos[:, None] > pos[None, :]
    diff = G[..., :, None] - G[..., None, :]
    decay = jnp.where(causal, jnp.exp(jnp.where(causal, diff, 0.0)), 0.0)
    k_beta = kc * bc[..., None]
    kk = jnp.einsum("bhnid,bhnjd->bhnij", k_beta, kc)
    lower = jnp.eye(c, dtype=f32) + jnp.where(strict, kk * decay, 0.0)
    rhs = jnp.concatenate([vc * bc[..., None], k_beta * jnp.exp(G)[..., None]], axis=-1)
    uw = lax.linalg.triangular_solve(lower, rhs, left_side=True, lower=True)
    u, w = uw[..., :dv], uw[..., dv:]
    attn = jnp.einsum("bhnid,bhnjd->bhnij", qc, kc) * decay
    xs = tuple(jnp.moveaxis(a, 2, 0) for a in (qc, kc, u, w, G, attn))
    s0 = jnp.zeros((b_, h, dk, dv), f32)

    def step(S, inp):
        q_n, k_n, u_n, w_n, g_n, a_n = inp
        v_new = u_n - jnp.einsum("bhid,bhde->bhie", w_n, S)
        o_n = (jnp.einsum("bhid,bhde->bhie", q_n * jnp.exp(g_n)[..., None], S)
               + jnp.einsum("bhij,bhje->bhie", a_n, v_new))
        g_last = g_n[..., -1]
        k_dec = k_n * jnp.exp(g_last[..., None] - g_n)[..., None]
        S = S * jnp.exp(g_last)[..., None, None] + jnp.einsum("bhid,bhie->bhde", k_dec, v_new)
        return S, o_n

    _, o = lax.scan(step, s0, xs)
    return _from_scan(o)


def gla_chunked(q, k, v, gk):
    f32 = jnp.float32
    q, k, v, gk = (a.astype(f32) for a in (q, k, v, gk))
    b_, t, h, dk = q.shape
    dv = v.shape[-1]
    c = GLA_CHUNK
    qc, kc, vc, gc = (_to_chunks(a, c) for a in (q, k, v, gk))
    Bc = jnp.cumsum(gc, axis=-2)
    pos = jnp.arange(c)
    causal = (pos[:, None] >= pos[None, :])[..., None]
    diff = Bc[..., :, None, :] - Bc[..., None, :, :]
    dec = jnp.where(causal, jnp.exp(jnp.where(causal, diff, 0.0)), 0.0)
    attn = jnp.einsum("bhnid,bhnjd,bhnijd->bhnij", qc, kc, dec)
    xs = tuple(jnp.moveaxis(a, 2, 0) for a in (qc, kc, vc, Bc, attn))
    s0 = jnp.zeros((b_, h, dk, dv), f32)

    def step(S, inp):
        q_n, k_n, v_n, b_n, a_n = inp
        o_n = (jnp.einsum("bhid,bhde->bhie", q_n * jnp.exp(b_n), S)
               + jnp.einsum("bhij,bhje->bhie", a_n, v_n))
        b_last = b_n[..., -1:, :]
        k_dec = k_n * jnp.exp(b_last - b_n)
        S = S * jnp.exp(b_last[..., 0, :])[..., None] + jnp.einsum("bhid,bhie->bhde", k_dec, v_n)
        return S, o_n

    _, o = lax.scan(step, s0, xs)
    return _from_scan(o)


def hybrid_layer(x, w_in, conv_w, dn_a_log, dn_dt_bias, gla_gate_w2, gla_gate_b,
                 dn_norm_g, gla_norm_g, w_out, ln_g, ln_b):
    bsz, t, _ = x.shape
    proj = jnp.einsum("btd,de->bte", x, w_in)
    (dn_q, dn_k, dn_v, dn_z, dn_b, dn_a,
     g_q, g_k, g_v, g_z, g_r) = _split(proj, IN_SIZES)

    dn_qkv = jax.nn.silu(causal_short_conv(jnp.concatenate([dn_q, dn_k, dn_v], axis=-1), conv_w))
    cq, ck, cv = _split(dn_qkv, (DN_KEY_WIDTH, DN_KEY_WIDTH, DN_WIDTH))
    q = l2norm(cq.reshape(bsz, t, DN_HEADS, DN_DK)) * (DN_DK ** -0.5)
    k = l2norm(ck.reshape(bsz, t, DN_HEADS, DN_DK))
    v = cv.reshape(bsz, t, DN_HEADS, DN_DV)
    beta = jax.nn.sigmoid(dn_b.astype(jnp.float32))
    g = -jnp.exp(dn_a_log.astype(jnp.float32)) * jax.nn.softplus(
        dn_a.astype(jnp.float32) + dn_dt_bias.astype(jnp.float32))
    o_dn = gated_delta_rule_chunked(q, k, v, g, beta)
    o_dn = head_rms_norm(o_dn, dn_norm_g) * jax.nn.silu(
        dn_z.reshape(bsz, t, DN_HEADS, DN_DV).astype(jnp.float32))

    gq = g_q.reshape(bsz, t, GLA_HEADS, GLA_DK) * (GLA_DK ** -0.5)
    gk = g_k.reshape(bsz, t, GLA_HEADS, GLA_DK)
    gv = g_v.reshape(bsz, t, GLA_HEADS, GLA_DV)
    gate_logits = jnp.einsum("btr,re->bte", g_r, gla_gate_w2) + gla_gate_b
    log_f = (jax.nn.log_sigmoid(gate_logits.astype(jnp.float32)) / GLA_TAU).reshape(
        bsz, t, GLA_HEADS, GLA_DK)
    o_gla = gla_chunked(gq, gk, gv, log_f)
    o_gla = head_rms_norm(o_gla, gla_norm_g) * jax.nn.silu(
        g_z.reshape(bsz, t, GLA_HEADS, GLA_DV).astype(jnp.float32))

    o = jnp.concatenate([o_dn.reshape(bsz, t, DN_WIDTH),
                         o_gla.reshape(bsz, t, GLA_WIDTH)], axis=-1).astype(x.dtype)
    y = jnp.einsum("bte,ed->btd", o, w_out)
    return layer_norm(DEEPNORM_ALPHA * x + y, ln_g, ln_b)


def setup_inputs(seed: int = 0) -> dict:
    key = jax.random.key(seed)
    ks = jax.random.split(key, 12)
    f32 = jnp.float32
    x = jax.random.normal(ks[0], (BATCH, SEQ, D_MODEL), f32)
    col_scale = jnp.concatenate([
        jnp.ones((2 * DN_KEY_WIDTH,), f32),
        jnp.full((DN_WIDTH,), DEEPNORM_BETA, f32),
        jnp.ones((DN_WIDTH + 2 * DN_HEADS + 2 * GLA_KEY_WIDTH,), f32),
        jnp.full((GLA_WIDTH,), DEEPNORM_BETA, f32),
        jnp.ones((GLA_WIDTH + GLA_GATE_RANK,), f32)])
    w_in = jax.random.normal(ks[1], (DEPTH, D_MODEL, D_IN_PROJ), f32) * (D_MODEL ** -0.5) * col_scale
    conv_w = jax.random.normal(ks[2], (DEPTH, DN_CONV, DN_KEY_WIDTH * 2 + DN_WIDTH), f32) * (DN_CONV ** -0.5)
    dn_a_log = jnp.log(jax.random.uniform(ks[3], (DEPTH, DN_HEADS), f32, 1.0, 16.0))
    dt = jnp.exp(jax.random.uniform(ks[4], (DEPTH, DN_HEADS), f32, math.log(1e-3), math.log(1e-1)))
    dn_dt_bias = dt + jnp.log(-jnp.expm1(-dt))
    gla_gate_w2 = jax.random.normal(ks[5], (DEPTH, GLA_GATE_RANK, GLA_KEY_WIDTH), f32) * (GLA_GATE_RANK ** -0.5)
    gla_gate_b = 0.1 * jax.random.normal(ks[6], (DEPTH, GLA_KEY_WIDTH), f32)
    dn_norm_g = 1.0 + 0.02 * jax.random.normal(ks[7], (DEPTH, DN_DV), f32)
    gla_norm_g = 1.0 + 0.02 * jax.random.normal(ks[8], (DEPTH, GLA_DV), f32)
    w_out = jax.random.normal(ks[9], (DEPTH, D_MIX, D_MODEL), f32) * (D_MIX ** -0.5) * DEEPNORM_BETA
    ln_g = 1.0 + 0.02 * jax.random.normal(ks[10], (DEPTH, D_MODEL), f32)
    ln_b = 0.02 * jax.random.normal(ks[11], (DEPTH, D_MODEL), f32)
    return {"x": x, "w_in": w_in, "conv_w": conv_w, "dn_a_log": dn_a_log,
            "dn_dt_bias": dn_dt_bias, "gla_gate_w2": gla_gate_w2, "gla_gate_b": gla_gate_b,
            "dn_norm_g": dn_norm_g, "gla_norm_g": gla_norm_g, "w_out": w_out,
            "ln_g": ln_g, "ln_b": ln_b}


def reference(x, w_in, conv_w, dn_a_log, dn_dt_bias, gla_gate_w2, gla_gate_b,
              dn_norm_g, gla_norm_g, w_out, ln_g, ln_b):
    h = x
    for l in range(DEPTH):
        h = hybrid_layer(h, w_in[l], conv_w[l], dn_a_log[l], dn_dt_bias[l],
                         gla_gate_w2[l], gla_gate_b[l], dn_norm_g[l], gla_norm_g[l],
                         w_out[l], ln_g[l], ln_b[l])
    return h
```

```cpp
#include <hip/hip_runtime.h>
#include <hip/hip_cooperative_groups.h>
#include <cstdio>
namespace cg = cooperative_groups;

#define LAS __attribute__((address_space(3)))
typedef unsigned short bf16_t;
typedef short bf16x8 __attribute__((ext_vector_type(8)));
typedef float f32x4 __attribute__((ext_vector_type(4)));
typedef unsigned u32x4 __attribute__((ext_vector_type(4)));
typedef unsigned u32x2 __attribute__((ext_vector_type(2)));

constexpr int SEQ = 2048, DM = 1024, MROWS = 16384, NPROJ = 3840, NTASK = 1024;
constexpr float DEEP_ALPHA = 1.41421356237f, EPS = 1e-6f;
constexpr size_t MiB = 1u << 20;
constexpr size_t WS_EGL = 0, WS_EBL = 65536, WS_SMALL = 1 * MiB, WS_WIN = 3 * MiB, WS_WOUT = 18 * MiB, WS_XB = 22 * MiB;
constexpr size_t WS_NEGW = 22 * MiB, WS_KDT = 38 * MiB;
constexpr size_t WS_DNZ = 54 * MiB, WS_GZ = 70 * MiB;
constexpr size_t WS_DNQ = 86 * MiB, WS_DNK = 102 * MiB, WS_DNV = 118 * MiB, WS_GQ = 134 * MiB, WS_GK = 142 * MiB, WS_GV = 150 * MiB;
constexpr size_t WS_DNST = 86 * MiB;
constexpr size_t WS_UT = 166 * MiB, WS_DQT = 182 * MiB, WS_DATT = 198 * MiB, WS_GQT = 206 * MiB, WS_GATT = 214 * MiB, WS_GVT = 222 * MiB, WS_GST = 238 * MiB;
constexpr size_t WS_Y = 166 * MiB, WS_END = 255 * MiB;
constexpr size_t WS_O = 118 * MiB;
constexpr size_t WS_CNT = 540672, WS_LNCNT = 544768, WS_XBUF = 254 * MiB;
constexpr size_t WIN_BYTES = (size_t)NPROJ * DM * 2, WOUT_BYTES = (size_t)DM * DM * 2;

typedef _Float16 h16x2 __attribute__((ext_vector_type(2)));
typedef _Float16 h16x8 __attribute__((ext_vector_type(8)));
__device__ __forceinline__ unsigned f2bf(float f) { return (unsigned)__builtin_bit_cast(unsigned short, (_Float16)f); }
__device__ __forceinline__ unsigned pk2(float lo, float hi) { h16x2 v = {(_Float16)lo, (_Float16)hi}; return __builtin_bit_cast(unsigned, v); }
__device__ __forceinline__ unsigned pkh2(float lo, float hi) { return pk2(lo, hi); }
__device__ __forceinline__ float bflo(unsigned w) { return (float)__builtin_bit_cast(h16x2, w).x; }
__device__ __forceinline__ float bfhi(unsigned w) { return (float)__builtin_bit_cast(h16x2, w).y; }
__device__ __forceinline__ float hlo(unsigned w) { return bflo(w); }
__device__ __forceinline__ float hhi(unsigned w) { return bfhi(w); }
__device__ __forceinline__ float h1f(bf16_t h) { return (float)__builtin_bit_cast(_Float16, h); }
__device__ __forceinline__ float bf1(bf16_t h) { return h1f(h); }
__device__ __forceinline__ bf16x8 pack8(f32x4 a, f32x4 b) { u32x4 w; w.x = pk2(a[0], a[1]); w.y = pk2(a[2], a[3]); w.z = pk2(b[0], b[1]); w.w = pk2(b[2], b[3]); return __builtin_bit_cast(bf16x8, w); }
__device__ __forceinline__ void unpack8(u32x4 w, float* o) { o[0] = bflo(w.x); o[1] = bfhi(w.x); o[2] = bflo(w.y); o[3] = bfhi(w.y); o[4] = bflo(w.z); o[5] = bfhi(w.z); o[6] = bflo(w.w); o[7] = bfhi(w.w); }
__device__ __forceinline__ void unpackh8(u32x4 w, float* o) { unpack8(w, o); }
__device__ __forceinline__ f32x4 mfma16(bf16x8 a, bf16x8 b, f32x4 c) { return __builtin_amdgcn_mfma_f32_16x16x32_f16(__builtin_bit_cast(h16x8, a), __builtin_bit_cast(h16x8, b), c, 0, 0, 0); }
__device__ __forceinline__ unsigned pki2(float lo, float hi) { const int a = (int)rintf(fminf(fmaxf(lo * 4096.f, -32767.f), 32767.f)), b = (int)rintf(fminf(fmaxf(hi * 4096.f, -32767.f), 32767.f)); return ((unsigned)a & 0xffffu) | ((unsigned)b << 16); }
__device__ __forceinline__ void unpacki8(u32x4 w, float* o) { const unsigned ww[4] = {w.x, w.y, w.z, w.w};
#pragma unroll
    for (int e = 0; e < 4; ++e) { o[2 * e] = (float)(short)(ww[e] & 0xffffu); o[2 * e + 1] = (float)(short)(ww[e] >> 16); } }
__device__ __forceinline__ float siluf(float x) { return x * __builtin_amdgcn_rcpf(1.f + __expf(-x)); }
__device__ __forceinline__ int il(int t, int m) { return 8 * (m >> 2) + 4 * t + (m & 3); }

constexpr float LO_SCALE = 2048.f;
__device__ __forceinline__ void split8(const float* v, u32x4& hi, u32x4& lo) {
    float r[8]; unsigned h[8];
#pragma unroll
    for (int e = 0; e < 8; ++e) { const _Float16 hh = (_Float16)v[e]; h[e] = (unsigned)__builtin_bit_cast(unsigned short, hh); r[e] = (v[e] - (float)hh) * LO_SCALE; }
    hi.x = h[0] | (h[1] << 16); hi.y = h[2] | (h[3] << 16); hi.z = h[4] | (h[5] << 16); hi.w = h[6] | (h[7] << 16);
    lo.x = pk2(r[0], r[1]); lo.y = pk2(r[2], r[3]); lo.z = pk2(r[4], r[5]); lo.w = pk2(r[6], r[7]);
}
__device__ __forceinline__ void lds_barrier() { asm volatile("s_waitcnt lgkmcnt(0)" ::: "memory"); __builtin_amdgcn_s_barrier(); asm volatile("" ::: "memory"); }
#define SCHED_FENCE() __builtin_amdgcn_sched_barrier(0)
__device__ __forceinline__ int otid() { int t = threadIdx.x; asm volatile("" : "+v"(t)); return t; }
namespace pg8 {
constexpr int BM = 256, BK = 64, HALF = 128, HTB = HALF * BK * 2, STAGE_BYTES = 8 * HTB, NXCD = 8, WGM = 4;
__device__ __forceinline__ int lds_byte(int r, int c) { const int st = (r >> 4) * 2 + (c >> 5), rr = r & 15, cc = c & 31, ob = rr * 64 + cc * 2; return st * 1024 + (ob ^ (((ob >> 9) & 1) << 5)); }
__device__ __forceinline__ void stage_rc(int b, int& R, int& C) { const int st = b / 1024, sb = b % 1024, swz = sb ^ (((sb >> 9) & 1) << 5); R = (st >> 1) * 16 + swz / 64; C = (st & 1) * 32 + (swz % 64) / 2; }
__device__ __forceinline__ int perm32(int rho) { const int n = rho >> 4, i = rho & 15; return 8 * (i >> 2) + 4 * n + (i & 3); }
struct Unit { int pm, pn; };
struct Gemm { const bf16_t* A; const bf16_t* Bt; int M, N, K; };
struct StaticOrder {
    int nM, nN, nwg, G, c;
    __device__ void init(int M, int N, int G_, int c_) { nM = M / BM; nN = N / BM; nwg = nM * nN; G = G_; c = c_; }
    __device__ bool next(int i, Unit& u) const {
        const long L = (long)i * G + c; if (L >= nwg) return false;
        int wgid = (int)L; { const int q = nwg / NXCD, r = nwg % NXCD, xcd = wgid % NXCD, off = wgid / NXCD; wgid = (xcd < r ? xcd * (q + 1) : r * (q + 1) + (xcd - r) * q) + off; }
        const int nig = WGM * nN, gid = wgid / nig, fm = gid * WGM, gsz = (nM - fm) < WGM ? (nM - fm) : WGM;
        u.pm = fm + ((wgid % nig) % gsz); u.pn = (wgid % nig) / gsz; return true;
    }
};

template <class Epi>
__device__ __forceinline__ void gemm_phase(LAS unsigned char* lds, const Gemm g, const StaticOrder& S, const Epi& E) {
    const int tid = otid(), wid = __builtin_amdgcn_readfirstlane(tid >> 6), lane = tid & 63, wr = wid >> 2, wc = wid & 3, fr = lane & 15, fq = lane >> 4;
    const int K = g.K, nt = K / BK;
    unsigned voffA[2], voffB[2];
#pragma unroll
    for (int i = 0; i < 2; ++i) { int R, C; stage_rc(tid * 16 + i * 8192, R, C); const int Rb = Epi::PERM ? ((R & ~31) + perm32(R & 31)) : R;
        voffA[i] = (unsigned)(R * K + C) * 2u; voffB[i] = (unsigned)(Rb * K + C) * 2u; }
    const size_t kstep = (size_t)(BK * 2);
    const size_t hstep = (size_t)HALF * K * 2;
    const size_t tstep = 2 * hstep;
    const unsigned ldsw = (unsigned)wid * 1024u;
    const int aoff = lds_byte(wr * 64 + fr, fq * 8), boff = lds_byte(wc * 32 + fr, fq * 8);
#define PG8_SA(b, h) (((b) * 2 + (h)) * HTB)
#define PG8_SB(b, h) ((4 + (b) * 2 + (h)) * HTB)
#define PG8_STAGE(bufoff, gbase, voff) do { _Pragma("unroll") for (int _i = 0; _i < 2; ++_i) \
        __builtin_amdgcn_global_load_lds((const unsigned*)((const char*)(gbase) + (voff)[_i]), (LAS unsigned*)(lds + (bufoff) + ldsw + _i * 8192), 16, 0, 0); } while (0)
#define PG8_LDA(dst, b, h) do { _Pragma("unroll") for (int m = 0; m < 4; ++m) _Pragma("unroll") for (int k = 0; k < 2; ++k) dst[m][k] = *(const LAS bf16x8*)(lds + PG8_SA(b, h) + aoff + m * 2048 + k * 1024); } while (0)
#define PG8_LDB(dst, b, h) do { _Pragma("unroll") for (int n = 0; n < 2; ++n) _Pragma("unroll") for (int k = 0; k < 2; ++k) dst[n][k] = *(const LAS bf16x8*)(lds + PG8_SB(b, h) + boff + n * 2048 + k * 1024); } while (0)
#define PG8_MMA(ai, bj, At, Bt) do { __builtin_amdgcn_s_setprio(1); _Pragma("unroll") for (int m = 0; m < 4; ++m) _Pragma("unroll") for (int n = 0; n < 2; ++n) _Pragma("unroll") for (int k = 0; k < 2; ++k) \
        acc[ai][bj][m][n] = __builtin_amdgcn_mfma_f32_16x16x32_f16(__builtin_bit_cast(h16x8, Bt[n][k]), __builtin_bit_cast(h16x8, At[m][k]), acc[ai][bj][m][n], 0, 0, 0); __builtin_amdgcn_s_setprio(0); } while (0)
#define PG8_WAIT_V(n) asm volatile("s_waitcnt vmcnt(" #n ")" ::: "memory")
#define PG8_WAIT_L(n) asm volatile("s_waitcnt lgkmcnt(" #n ")" ::: "memory")
#define PG8_BAR __builtin_amdgcn_s_barrier()
#define PG8_SCHED __builtin_amdgcn_sched_barrier(0)
    Unit cur, nxt; int ui = 0;
    if (!S.next(0, cur)) return;
    f32x4 acc[2][2][4][2];
#pragma unroll
    for (int a = 0; a < 2; ++a)
#pragma unroll
        for (int b = 0; b < 2; ++b)
#pragma unroll
            for (int m = 0; m < 4; ++m)
#pragma unroll
                for (int n = 0; n < 2; ++n) acc[a][b][m][n] = (f32x4){0.f, 0.f, 0.f, 0.f};
    bf16x8 At[4][2], B0[2][2], B1[2][2];
    const char* cA = (const char*)g.A + (size_t)cur.pm * tstep; const char* cB = (const char*)g.Bt + (size_t)cur.pn * tstep;
    PG8_STAGE(PG8_SB(0, 0), cB, voffB); PG8_STAGE(PG8_SA(0, 0), cA, voffA); PG8_STAGE(PG8_SB(0, 1), cB + hstep, voffB); PG8_STAGE(PG8_SA(0, 1), cA + hstep, voffA);
    if (wr == 1) PG8_BAR;
    PG8_WAIT_V(4); PG8_BAR;
    PG8_STAGE(PG8_SB(1, 0), cB + kstep, voffB); PG8_STAGE(PG8_SA(1, 0), cA + kstep, voffA); PG8_STAGE(PG8_SB(1, 1), cB + hstep + kstep, voffB);
    PG8_WAIT_V(6); PG8_BAR;
    for (;;) {
        const bool has_next = S.next(ui + 1, nxt);
        const char* nA = has_next ? (const char*)g.A + (size_t)nxt.pm * tstep : cA; const char* nB = has_next ? (const char*)g.Bt + (size_t)nxt.pn * tstep : cB;
        for (int t = 0; t < nt; t += 2) {
            const bool last = (t == nt - 2);
            const char* a1 = cA + (size_t)(t + 1) * kstep;
            const char* a2 = last ? nA : cA + (size_t)(t + 2) * kstep; const char* b2 = last ? nB : cB + (size_t)(t + 2) * kstep;
            const char* a3 = a2 + kstep; const char* b3 = b2 + kstep;
            PG8_LDB(B0, 0, 0); PG8_SCHED; PG8_LDA(At, 0, 0); PG8_STAGE(PG8_SA(1, 1), a1 + hstep, voffA);
            PG8_WAIT_L(8); PG8_BAR; PG8_WAIT_L(0); PG8_MMA(0, 0, At, B0); PG8_BAR; PG8_SCHED;
            PG8_LDB(B1, 0, 1); PG8_STAGE(PG8_SB(0, 0), b2, voffB);
            PG8_BAR; PG8_WAIT_L(0); PG8_MMA(0, 1, At, B1); PG8_BAR;
            PG8_LDA(At, 0, 1); PG8_STAGE(PG8_SA(0, 0), a2, voffA);
            PG8_BAR; PG8_WAIT_L(0); PG8_MMA(1, 0, At, B0); PG8_BAR; PG8_SCHED;
            PG8_STAGE(PG8_SB(0, 1), b2 + hstep, voffB);
            PG8_WAIT_V(6); PG8_BAR; PG8_MMA(1, 1, At, B1); PG8_BAR;
            PG8_LDB(B0, 1, 0); PG8_SCHED; PG8_LDA(At, 1, 0); PG8_STAGE(PG8_SA(0, 1), a2 + hstep, voffA);
            PG8_WAIT_L(8); PG8_BAR; PG8_WAIT_L(0); PG8_MMA(0, 0, At, B0); PG8_BAR; PG8_SCHED;
            PG8_LDB(B1, 1, 1); PG8_STAGE(PG8_SB(1, 0), b3, voffB);
            PG8_BAR; PG8_WAIT_L(0); PG8_MMA(0, 1, At, B1); PG8_BAR;
            PG8_LDA(At, 1, 1); PG8_STAGE(PG8_SA(1, 0), a3, voffA);
            PG8_BAR; PG8_WAIT_L(0); PG8_MMA(1, 0, At, B0); PG8_BAR; PG8_SCHED;
            PG8_STAGE(PG8_SB(1, 1), b3 + hstep, voffB);
            PG8_WAIT_V(6); PG8_BAR; PG8_MMA(1, 1, At, B1); PG8_BAR;
        }
        if constexpr (!Epi::AFTER_DRAIN) E(acc, cur, wr, wc, fr, fq);
        if (!has_next) break;
#pragma unroll
        for (int a = 0; a < 2; ++a)
#pragma unroll
            for (int b = 0; b < 2; ++b)
#pragma unroll
                for (int m = 0; m < 4; ++m)
#pragma unroll
                    for (int n = 0; n < 2; ++n) acc[a][b][m][n] = (f32x4){0.f, 0.f, 0.f, 0.f};
        cur = nxt; cA = nA; cB = nB; ++ui;
    }
    PG8_WAIT_V(0);
    if (wr == 0) PG8_BAR;
    PG8_BAR;
    if constexpr (Epi::AFTER_DRAIN) E.fused(acc, cur, wr, wc, fr, fq, lds, wid, lane);
#undef PG8_SA
#undef PG8_SB
#undef PG8_STAGE
#undef PG8_LDA
#undef PG8_LDB
#undef PG8_MMA
#undef PG8_WAIT_V
#undef PG8_WAIT_L
#undef PG8_BAR
#undef PG8_SCHED
}
}

struct EpiProj {
    static constexpr bool PERM = true, AFTER_DRAIN = false;
    unsigned char* ws;
    __device__ __forceinline__ void operator()(const f32x4 (&acc)[2][2][4][2], const pg8::Unit& u, int wr, int wc, int fr, int fq) const {
        const int pn = u.pn; const int row0 = u.pm * 256 + wr * 64 + fr;
        if (pn < 14) {
            size_t off; int ldc, colt;
            if (pn < 8) { off = (pn >> 1) == 3 ? WS_DNZ : WS_DNQ + (size_t)(pn >> 1) * 16 * MiB; ldc = 512; colt = (pn & 1) * 256; }
            else if (pn == 8) { off = WS_GQ; ldc = 256; colt = 0; }
            else if (pn == 9) { off = WS_GK; ldc = 256; colt = 0; }
            else if (pn < 12) { off = WS_GV; ldc = 512; colt = (pn - 10) * 256; }
            else { off = WS_GZ; ldc = 512; colt = (pn - 12) * 256; }
            bf16_t* base = (bf16_t*)(ws + off);
            const int col0 = colt + wc * 32 + 8 * fq;
#pragma unroll
            for (int ai = 0; ai < 2; ++ai)
#pragma unroll
                for (int m = 0; m < 4; ++m) { bf16_t* rowp = base + (size_t)(row0 + ai * 128 + m * 16) * ldc + col0;
#pragma unroll
                    for (int bj = 0; bj < 2; ++bj) { const f32x4 v0 = acc[ai][bj][m][0], v1 = acc[ai][bj][m][1];
                        u32x4 w;
                        if (pn < 4) { w.x = pki2(v0[0], v0[1]); w.y = pki2(v0[2], v0[3]); w.z = pki2(v1[0], v1[1]); w.w = pki2(v1[2], v1[3]); }
                        else { w.x = pkh2(v0[0], v0[1]); w.y = pkh2(v0[2], v0[3]); w.z = pkh2(v1[0], v1[1]); w.w = pkh2(v1[2], v1[3]); }
                        *(u32x4*)(rowp + bj * 128) = w; } }
        } else if (wc == 0) {
            float* sm = (float*)(ws + WS_SMALL);
#pragma unroll
            for (int ai = 0; ai < 2; ++ai)
#pragma unroll
                for (int m = 0; m < 4; ++m) { float* rowp = sm + (size_t)(row0 + ai * 128 + m * 16) * 32 + 8 * fq;
                    *(f32x4*)(rowp) = acc[ai][0][m][0]; *(f32x4*)(rowp + 4) = acc[ai][0][m][1]; }
        }
    }
};
struct EpiOutLN {
    static constexpr bool PERM = false, AFTER_DRAIN = true;
    const float* resid; float* out; bf16_t* xb; const float* lng; const float* lnb; unsigned* xbuf; unsigned* cnt;
    __device__ __forceinline__ void operator()(const f32x4 (&)[2][2][4][2], const pg8::Unit&, int, int, int, int) const {}
    __device__ __forceinline__ void fused(f32x4 (&acc)[2][2][4][2], const pg8::Unit& u, int wr, int wc, int fr, int fq, LAS unsigned char* lds, int wid, int lane) const {
        typedef float f32x2v __attribute__((ext_vector_type(2)));
        LAS f32x2v* P = (LAS f32x2v*)lds;
        LAS f32x2v* S = (LAS f32x2v*)(lds + 8192);
        const int col0 = u.pn * 256 + wc * 32 + 4 * fq;
        f32x4 rb[2][4];
#pragma unroll
        for (int i = 0; i < 4; ++i) rb[0][i] = *(const f32x4*)(resid + (size_t)(u.pm * 256 + wr * 64 + fr) * DM + col0 + (i >> 1) * 128 + (i & 1) * 16);
#pragma unroll
        for (int g = 0; g < 8; ++g) {
            const int ai = g >> 2, m = g & 3;
            if (g + 1 < 8) { const int ai1 = (g + 1) >> 2, m1 = (g + 1) & 3; const size_t off1 = (size_t)(u.pm * 256 + ai1 * 128 + wr * 64 + m1 * 16 + fr) * DM + col0;
#pragma unroll
                for (int i = 0; i < 4; ++i) rb[(g + 1) & 1][i] = *(const f32x4*)(resid + off1 + (i >> 1) * 128 + (i & 1) * 16); }
#pragma unroll
            for (int i = 0; i < 4; ++i) acc[ai][i >> 1][m][i & 1] = rb[g & 1][i] * DEEP_ALPHA + acc[ai][i >> 1][m][i & 1];
            asm volatile("" : "+v"(acc[ai][0][m][0]), "+v"(acc[ai][0][m][1]), "+v"(acc[ai][1][m][0]), "+v"(acc[ai][1][m][1]));
            SCHED_FENCE();
        }
#pragma unroll
        for (int ai = 0; ai < 2; ++ai)
#pragma unroll
            for (int m = 0; m < 4; ++m) {
                float s = 0.f;
#pragma unroll
                for (int bj = 0; bj < 2; ++bj)
#pragma unroll
                    for (int n = 0; n < 2; ++n) { const f32x4 x = acc[ai][bj][m][n]; s += (x[0] + x[1]) + (x[2] + x[3]); }
                s += __shfl_xor(s, 16); s += __shfl_xor(s, 32);
                const float mw = s * (1.0f / 64.0f); float qq = 0.f;
#pragma unroll
                for (int bj = 0; bj < 2; ++bj)
#pragma unroll
                    for (int n = 0; n < 2; ++n) { const f32x4 d = acc[ai][bj][m][n] - mw; qq += (d[0] * d[0] + d[1] * d[1]) + (d[2] * d[2] + d[3] * d[3]); }
                qq += __shfl_xor(qq, 16); qq += __shfl_xor(qq, 32);
                if (fq == 0) P[(ai * 128 + wr * 64 + m * 16 + fr) * 4 + wc] = (f32x2v){mw, qq};
            }
        asm volatile("s_waitcnt lgkmcnt(0)" ::: "memory"); __builtin_amdgcn_s_barrier(); asm volatile("" ::: "memory");
        const int row = wid * 32 + (lane & 31);
        if (lane < 32) {
            const f32x2v pa = P[row * 4 + 0], pb = P[row * 4 + 1], pc = P[row * 4 + 2], pd = P[row * 4 + 3];
            const float mt = (pa.x + pb.x + pc.x + pd.x) * 0.25f;
            const float da = pa.x - mt, db = pb.x - mt, dc = pc.x - mt, dd = pd.x - mt;
            const float m2 = (pa.y + pb.y) + (pc.y + pd.y) + 64.0f * ((da * da + db * db) + (dc * dc + dd * dd));
            unsigned long long* slot = (unsigned long long*)xbuf + ((size_t)(u.pm * 256 + row) * 4 + u.pn);
            __hip_atomic_store(slot, ((unsigned long long)__float_as_uint(m2) << 32) | __float_as_uint(mt), __ATOMIC_RELAXED, __HIP_MEMORY_SCOPE_AGENT);
        }
        asm volatile("s_waitcnt vmcnt(0)" ::: "memory");
        if (lane == 0) __hip_atomic_fetch_add(cnt + 64 * u.pm, 1u, __ATOMIC_RELAXED, __HIP_MEMORY_SCOPE_AGENT);
        if (wid == 0) {
            unsigned sp = 0;
            while ((unsigned)__builtin_amdgcn_readfirstlane(__hip_atomic_load(cnt + 64 * u.pm, __ATOMIC_RELAXED, __HIP_MEMORY_SCOPE_AGENT)) < 32u) { __builtin_amdgcn_s_sleep(2); if (++sp > (1u << 24)) break; }
            __builtin_amdgcn_fence(__ATOMIC_ACQUIRE, "agent");
        }
        asm volatile("s_waitcnt vmcnt(0) lgkmcnt(0)" ::: "memory"); __builtin_amdgcn_s_barrier(); asm volatile("" ::: "memory");
        if (lane < 32) {
            const unsigned long long* slot = (const unsigned long long*)xbuf + (size_t)(u.pm * 256 + row) * 4; float mt[4], m2[4]; float ms = 0.f;
#pragma unroll
            for (int t = 0; t < 4; ++t) { const unsigned long long wv = __hip_atomic_load(slot + t, __ATOMIC_RELAXED, __HIP_MEMORY_SCOPE_AGENT); mt[t] = __uint_as_float((unsigned)wv); m2[t] = __uint_as_float((unsigned)(wv >> 32)); ms += mt[t]; }
            const float mean = ms * 0.25f; float qq = 0.f;
#pragma unroll
            for (int t = 0; t < 4; ++t) { const float dm = mt[t] - mean; qq += m2[t] + 256.0f * dm * dm; }
            S[row] = (f32x2v){mean, rsqrtf(qq * (1.0f / 1024.0f) + EPS)};
        }
        asm volatile("s_waitcnt lgkmcnt(0)" ::: "memory"); __builtin_amdgcn_s_barrier(); asm volatile("" ::: "memory");
#pragma unroll
        for (int ai = 0; ai < 2; ++ai)
#pragma unroll
            for (int m = 0; m < 4; ++m) { const int r = ai * 128 + wr * 64 + m * 16 + fr; const f32x2v sr = S[r]; const size_t off = (size_t)(u.pm * 256 + r) * DM + col0;
#pragma unroll
                for (int bj = 0; bj < 2; ++bj)
#pragma unroll
                    for (int n = 0; n < 2; ++n) { const f32x4 gg = *(const f32x4*)(lng + col0 + bj * 128 + n * 16), bb = *(const f32x4*)(lnb + col0 + bj * 128 + n * 16);
                        const f32x4 o = (acc[ai][bj][m][n] - sr.x) * sr.y * gg + bb;
                        *(f32x4*)(out + off + bj * 128 + n * 16) = o;
                        if (xb) { u32x2 wv; wv.x = pkh2(o[0], o[1]); wv.y = pkh2(o[2], o[3]); *(u32x2*)(xb + off + bj * 128 + n * 16) = wv; } }
                SCHED_FENCE(); }
    }
};

#define XB_TMO      128
#define XB_XCNT(j)  (256  + 64 * (j))
#define XB_XSUB(j)  (1280 + 64 * (j))
#define XB_XGEN(j)  (2304 + 64 * (j))
#define XB_TOP      3328
#define XB_TOPGEN   3392
#define XCD_BAR_WORDS 3456
#define XB_SPIN_CAP (1u << 22)
__device__ __forceinline__ unsigned xb_ld(unsigned* p)              { return __hip_atomic_load(p, __ATOMIC_RELAXED, __HIP_MEMORY_SCOPE_AGENT); }
__device__ __forceinline__ unsigned xb_add(unsigned* p, unsigned v) { return __hip_atomic_fetch_add(p, v, __ATOMIC_RELAXED, __HIP_MEMORY_SCOPE_AGENT); }
__device__ __forceinline__ unsigned xb_xcc_id() { return (unsigned)__builtin_amdgcn_s_getreg((3 << 11) | 20) & 0xFu; }
#define XB_SPIN(cond, bar) do { unsigned _sp = 0; while (cond) { __builtin_amdgcn_s_sleep(4); \
    if ((++_sp & 255u) == 0u) { if (xb_ld(&(bar)[XB_TMO])) break; if (_sp > XB_SPIN_CAP) { atomicAdd(&(bar)[XB_TMO], 1u); break; } } } } while (0)
struct XcdBarrier { unsigned* bar; unsigned x; volatile LAS unsigned* st; };
__device__ __forceinline__ XcdBarrier xcd_barrier_post(unsigned* bar, volatile LAS unsigned* st) {
    XcdBarrier b; b.bar = bar; b.x = xb_xcc_id(); b.st = st;
    if (threadIdx.x == 0) (void)xb_add(&bar[XB_XCNT(b.x)], 1u);
    return b;
}
__device__ __forceinline__ void xcd_barrier_complete(unsigned* bar, unsigned x, unsigned& nloc, unsigned& nx) {
    const unsigned G = gridDim.x * gridDim.y * gridDim.z;
    unsigned sum, cnt, mine, sp = 0u;
    for (;;) {
        sum = 0u; cnt = 0u; mine = 0u;
#pragma unroll
        for (unsigned j = 0; j < 16; ++j) { const unsigned c = xb_ld(&bar[XB_XCNT(j)]); sum += c; cnt += (c > 0u) ? 1u : 0u; mine = (j == x) ? c : mine; }
        if (sum == G) break;
        __builtin_amdgcn_s_sleep(1);
        if ((++sp & 255u) == 0u) { if (xb_ld(&bar[XB_TMO])) break; if (sp > XB_SPIN_CAP) { atomicAdd(&bar[XB_TMO], 1u); break; } }
    }
    nloc = mine > 0u ? mine : 1u; nx = cnt > 0u ? cnt : 1u;
}
__device__ __forceinline__ void xcd_barrier(const XcdBarrier& b) {
    asm volatile("s_waitcnt vmcnt(0)" ::: "memory");
    __syncthreads();
    if (threadIdx.x == 0) {
        unsigned* bar = b.bar;
        __builtin_amdgcn_s_waitcnt(0);
        unsigned nloc = b.st[0], nx = b.st[1];
        if (nloc == 0u) { xcd_barrier_complete(bar, b.x, nloc, nx); b.st[0] = nloc; b.st[1] = nx; }
        const unsigned old = xb_add(&bar[XB_XSUB(b.x)], 1u);
        const unsigned gen = old / nloc;
        if (old + 1u == (gen + 1u) * nloc) {
            __builtin_amdgcn_fence(__ATOMIC_RELEASE, "agent");
            asm volatile("s_waitcnt vmcnt(0)" ::: "memory");
            const unsigned og = xb_add(&bar[XB_TOP], 1u);
            const unsigned tg = og / nx;
            if (og + 1u == (tg + 1u) * nx) xb_add(&bar[XB_TOPGEN], 1u);
            else XB_SPIN(xb_ld(&bar[XB_TOPGEN]) == tg, bar);
            __builtin_amdgcn_fence(__ATOMIC_ACQUIRE, "agent");
            xb_add(&bar[XB_XGEN(b.x)], 1u);
            asm volatile("s_waitcnt vmcnt(0)" ::: "memory");
        } else {
            XB_SPIN(xb_ld(&bar[XB_XGEN(b.x)]) == gen, bar);
            __builtin_amdgcn_fence(__ATOMIC_ACQUIRE, "agent");
            asm volatile("s_waitcnt vmcnt(0)" ::: "memory");
        }
    }
    __syncthreads();
}
constexpr size_t WS_BAR = 524288;

struct Args {
    const float *x, *w_in, *conv_w, *a_log, *dt_bias, *gw2, *gb, *dn_g, *gla_g, *w_out, *ln_g, *ln_b;
    float* out; unsigned char* ws; int ph_lo, ph_hi;
};

__device__ __forceinline__ int win_src_col(int r) { return r < 2048 ? r : (r < 3584 ? r + 8 : (r < 3592 ? r - 1536 : (r < 3608 ? r : -1))); }
template <bool MAP>
__device__ __forceinline__ void transpose_item(const float* W, int ldw, bf16_t* WT, int nblk, float* scr, int item, int lane) {
    const int kb = item / nblk, nb = item % nblk, k0 = 64 * kb, n0 = 32 * nb;
    const int kk = lane >> 3, n4 = lane & 7;
    const int sc = MAP ? win_src_col(n0 + 4 * n4) : n0 + 4 * n4;
    f32x4 v[8];
#pragma unroll
    for (int i = 0; i < 8; ++i) v[i] = sc >= 0 ? *(const f32x4*)(W + (size_t)(k0 + 8 * i + kk) * ldw + sc) : (f32x4){0.f, 0.f, 0.f, 0.f};
#pragma unroll
    for (int i = 0; i < 8; ++i) { float* s = scr + (8 * i + kk) * 33 + 4 * n4; s[0] = v[i][0]; s[1] = v[i][1]; s[2] = v[i][2]; s[3] = v[i][3]; }
    asm volatile("s_waitcnt lgkmcnt(0)" ::: "memory");
    const int c = lane & 7;
#pragma unroll
    for (int j = 0; j < 4; ++j) { const int n = (lane >> 3) + 8 * j; const float* s = scr + (8 * c) * 33 + n;
        u32x4 o; o.x = pkh2(s[0 * 33], s[1 * 33]); o.y = pkh2(s[2 * 33], s[3 * 33]); o.z = pkh2(s[4 * 33], s[5 * 33]); o.w = pkh2(s[6 * 33], s[7 * 33]);
        *(u32x4*)(WT + (size_t)(n0 + n) * 1024 + k0 + 8 * c) = o; }
    asm volatile("s_waitcnt lgkmcnt(0)" ::: "memory");
}

__device__ __forceinline__ void convert_weights(const Args& a, int l, int gw, int ngw, float* scr, int lane) {
    constexpr int I_IN = 16 * (NPROJ / 32), I_OUT = 16 * 32;
    for (int r = gw; r < I_IN + I_OUT; r += ngw) {
        if (r < I_IN) transpose_item<true>(a.w_in + (size_t)l * DM * 3608, 3608, (bf16_t*)(a.ws + WS_WIN + l * WIN_BYTES), NPROJ / 32, scr, r, lane);
        else transpose_item<false>(a.w_out + (size_t)l * DM * DM, DM, (bf16_t*)(a.ws + WS_WOUT + l * WOUT_BYTES), 32, scr, r - I_IN, lane);
    }
}
__device__ __forceinline__ void prologue(const Args& a, unsigned char* lds) {
    const int tid = otid(), lane = tid & 63, wave = tid >> 6, G = gridDim.x;
    float* scr = (float*)(lds + wave * 8448);
    const int gw = blockIdx.x * 8 + wave, NGW = G * 8;
    convert_weights(a, 0, gw, NGW, scr, lane);
    const size_t n8 = (size_t)MROWS * DM / 8;
    u32x4* xb = (u32x4*)(a.ws + WS_XB);
    for (size_t i = (size_t)blockIdx.x * 512 + tid; i < n8; i += (size_t)G * 512) {
        const f32x4 v0 = ((const f32x4*)a.x)[2 * i], v1 = ((const f32x4*)a.x)[2 * i + 1];
        u32x4 w; w.x = pkh2(v0[0], v0[1]); w.y = pkh2(v0[2], v0[3]); w.z = pkh2(v1[0], v1[1]); w.w = pkh2(v1[2], v1[3]); xb[i] = w;
    }
}

constexpr int L_KS = 0, L_QS = 17408, L_RT = 34816, L_AF = 71680, L_TB = 89088, L_KD = 98304, L_SG = 116736, L_QL = 117248, L_KL = 134656, L_CW = 152064;
__device__ __forceinline__ void load5(const bf16_t* raw, int tloc, u32x4* rows) {
#pragma unroll
    for (int r = 0; r < 5; ++r) rows[r] = (tloc + r - 3 >= 0) ? *(const u32x4*)(raw + (ptrdiff_t)(r - 3) * 512) : (u32x4){0u, 0u, 0u, 0u};
}
template <bool I16>
__device__ __forceinline__ void conv2(const u32x4* rows, const float* cw, float* o0, float* o1) {
    float xr[5][8];
#pragma unroll
    for (int r = 0; r < 5; ++r) { if (I16) unpacki8(rows[r], xr[r]); else unpackh8(rows[r], xr[r]); }
#pragma unroll
    for (int e = 0; e < 8; ++e) { o0[e] = 0.f; o1[e] = 0.f; }
#pragma unroll
    for (int tap = 0; tap < 4; ++tap) {
        const f32x4 w0 = *(const f32x4*)(cw + tap * 128), w1 = *(const f32x4*)(cw + tap * 128 + 4);
#pragma unroll
        for (int e = 0; e < 4; ++e) { o0[e] += w0[e] * xr[tap][e]; o0[4 + e] += w1[e] * xr[tap][4 + e]; o1[e] += w0[e] * xr[tap + 1][e]; o1[4 + e] += w1[e] * xr[tap + 1][4 + e]; }
    }
#pragma unroll
    for (int e = 0; e < 8; ++e) { o0[e] = siluf(o0[e]); o1[e] = siluf(o1[e]); }
}
__device__ __forceinline__ float sum16(float v) { v += __shfl_xor(v, 1); v += __shfl_xor(v, 2); v += __shfl_xor(v, 4); v += __shfl_xor(v, 8); return v; }

struct DnPre { u32x4 rq[5]; float bl, al; };
__device__ __forceinline__ void dn_preload(const Args& a, int task, int tid, DnPre& p) {
    const int bh = task >> 5, n = task & 31, b = bh >> 2, h = bh & 3; const size_t tok0 = (size_t)b * SEQ + 64 * n;
    const int tp = tid >> 4, c = tid & 15, t0 = 2 * tp; const size_t ro = (tok0 + t0) * 512 + 128 * h + 8 * c;
    load5((const bf16_t*)(a.ws + WS_DNQ) + ro, 64 * n + t0, p.rq);
    if (tid < 64) { const float* sm = (const float*)(a.ws + WS_SMALL) + (tok0 + tid) * 32; p.bl = sm[h]; p.al = sm[4 + h]; }
}
__device__ __forceinline__ void dn_prep(const Args& a, int l, int task, int next, DnPre& P, float dtb, float nexpa, unsigned char* lds) {
    const int tid = otid(), lane = tid & 63, wave = __builtin_amdgcn_readfirstlane(tid >> 6), m = lane & 15, q = lane >> 4;
    const int bh = task >> 5, n = task & 31, b = bh >> 2, h = bh & 3;
    unsigned char* ws = a.ws;
    bf16_t* KS = (bf16_t*)(lds + L_KS); bf16_t* QS = (bf16_t*)(lds + L_QS); bf16_t* RT = (bf16_t*)(lds + L_RT);
    float* AF = (float*)(lds + L_AF); bf16_t* TB = (bf16_t*)(lds + L_TB); bf16_t* KD = (bf16_t*)(lds + L_KD); float* SG = (float*)(lds + L_SG);
    bf16_t* QL = (bf16_t*)(lds + L_QL); bf16_t* KL = (bf16_t*)(lds + L_KL);
    const size_t tok0 = (size_t)b * SEQ + 64 * n;
    u32x4 rq[5], rk[5], rv[5];
#pragma unroll
    for (int r = 0; r < 5; ++r) rq[r] = P.rq[r];
    { const int tp = tid >> 4, c = tid & 15, t0 = 2 * tp; const size_t ro = ((size_t)b * SEQ + 64 * n + t0) * 512 + 128 * h + 8 * c;
      load5((const bf16_t*)(ws + WS_DNK) + ro, 64 * n + t0, rk); load5((const bf16_t*)(ws + WS_DNV) + ro, 64 * n + t0, rv); }
    if (wave == 0) {
        const float bl = P.bl, al = P.al;
        const float beta = __builtin_amdgcn_rcpf(1.f + __expf(-bl));
        const float xs = al + dtb;
        const float ee = __expf(-fabsf(xs));
        const float l1p = ee < 0.03f ? ee * (1.f - ee * (0.5f - ee * 0.33333333f)) : __logf(1.f + ee);
        const float sp = fmaxf(xs, 0.f) + l1p;
        float g = nexpa * sp;
#pragma unroll
        for (int o = 1; o < 64; o <<= 1) { const float t = __shfl_up(g, o); if (lane >= o) g += t; }
        SG[lane] = g; SG[64 + lane] = beta;
    }
    lds_barrier();
    {
        const int tp = tid >> 4, c = tid & 15, t0 = 2 * tp;
        const float G0 = SG[t0], G1 = SG[t0 + 1], be0 = SG[64 + t0], be1 = SG[64 + t0 + 1], Gl = SG[63];
        const int tsw = 2 * (tp ^ (4 * (c & 7)));
        const float* cw = (const float*)(lds + L_CW) + 8 * c;
        float o0[8], o1[8];
        conv2<true>(rq, cw, o0, o1);
        {
            float s0 = 0.f, s1 = 0.f;
#pragma unroll
            for (int e = 0; e < 8; ++e) { s0 += o0[e] * o0[e]; s1 += o1[e] * o1[e]; }
            s0 = sum16(s0); s1 = sum16(s1);
            const float r0 = rsqrtf(s0 + EPS) * 0.08838834764831845f, r1 = rsqrtf(s1 + EPS) * 0.08838834764831845f;
            u32x4 w0, w1, g0, g1; const float e0 = __expf(G0) * 128.f, e1 = __expf(G1) * 128.f;
#pragma unroll
            for (int e = 0; e < 8; ++e) { o0[e] *= r0; o1[e] *= r1; }
            { u32x4 l0, l1; split8(o0, w0, l0); split8(o1, w1, l1); *(u32x4*)(QL + t0 * 136 + 8 * c) = l0; *(u32x4*)(QL + (t0 + 1) * 136 + 8 * c) = l1; }
            *(u32x4*)(QS + t0 * 136 + 8 * c) = w0; *(u32x4*)(QS + (t0 + 1) * 136 + 8 * c) = w1;
            g0.x = pk2(o0[0] * e0, o0[1] * e0); g0.y = pk2(o0[2] * e0, o0[3] * e0); g0.z = pk2(o0[4] * e0, o0[5] * e0); g0.w = pk2(o0[6] * e0, o0[7] * e0);
            g1.x = pk2(o1[0] * e1, o1[1] * e1); g1.y = pk2(o1[2] * e1, o1[3] * e1); g1.z = pk2(o1[4] * e1, o1[5] * e1); g1.w = pk2(o1[6] * e1, o1[7] * e1);
            bf16_t* qt = (bf16_t*)(ws + WS_DQT) + (size_t)task * 8192;
            *(u32x4*)(qt + t0 * 128 + 8 * c) = g0; *(u32x4*)(qt + (t0 + 1) * 128 + 8 * c) = g1;
        }
        conv2<true>(rk, cw + 512, o0, o1);
        {
            float s0 = 0.f, s1 = 0.f;
#pragma unroll
            for (int e = 0; e < 8; ++e) { s0 += o0[e] * o0[e]; s1 += o1[e] * o1[e]; }
            s0 = sum16(s0); s1 = sum16(s1);
            const float r0 = rsqrtf(s0 + EPS), r1 = rsqrtf(s1 + EPS);
#pragma unroll
            for (int e = 0; e < 8; ++e) { o0[e] *= r0; o1[e] *= r1; }
            u32x4 w0, w1;
            { u32x4 l0, l1; split8(o0, w0, l0); split8(o1, w1, l1); *(u32x4*)(KL + t0 * 136 + 8 * c) = l0; *(u32x4*)(KL + (t0 + 1) * 136 + 8 * c) = l1; }
            *(u32x4*)(KS + t0 * 136 + 8 * c) = w0; *(u32x4*)(KS + (t0 + 1) * 136 + 8 * c) = w1;
            const float kb0 = be0 * __expf(G0), kb1 = be1 * __expf(G1), kd0 = __expf(Gl - G0), kd1 = __expf(Gl - G1);
#pragma unroll
            for (int e = 0; e < 8; ++e) {
                *(unsigned*)(RT + (128 + 8 * c + e) * 72 + tsw) = pk2(o0[e] * kb0, o1[e] * kb1);
                *(unsigned*)(KD + (8 * c + e) * 72 + tsw) = pk2(o0[e] * kd0, o1[e] * kd1);
            }
        }
        conv2<false>(rv, cw + 1024, o0, o1);
#pragma unroll
        for (int e = 0; e < 8; ++e) *(unsigned*)(RT + (8 * c + e) * 72 + tsw) = pk2(o0[e] * be0, o1[e] * be1);
    }
    lds_barrier();
    if (next >= 0) dn_preload(a, next, tid, P);
    {
        bf16_t* att = (bf16_t*)(ws + WS_DATT) + (size_t)task * 4096;
        const int na = wave < 2 ? 2 : 1;
        for (int ja = 0; ja < na; ++ja) {
            const int aa = wave + 8 * ja;
            const int Tj = aa < 4 ? 0 : (aa < 7 ? 1 : (aa < 9 ? 2 : 3)), Ti = aa - (Tj == 0 ? 0 : (Tj == 1 ? 3 : (Tj == 2 ? 5 : 6)));
            f32x4 acc = {0.f, 0.f, 0.f, 0.f}, accl = {0.f, 0.f, 0.f, 0.f};
            bf16x8 fav[4], fbv[4], fal[4], fbl[4];
#pragma unroll
            for (int ks = 0; ks < 4; ++ks) {
                fav[ks] = *(const bf16x8*)(KS + (16 * Tj + m) * 136 + 32 * ks + 8 * q); fbv[ks] = *(const bf16x8*)(QS + (16 * Ti + m) * 136 + 32 * ks + 8 * q);
                fal[ks] = *(const bf16x8*)(KL + (16 * Tj + m) * 136 + 32 * ks + 8 * q); fbl[ks] = *(const bf16x8*)(QL + (16 * Ti + m) * 136 + 32 * ks + 8 * q);
            }
            SCHED_FENCE();
#pragma unroll
            for (int ks = 0; ks < 4; ++ks) { accl = mfma16(fal[ks], fbv[ks], accl); acc = mfma16(fav[ks], fbv[ks], acc); accl = mfma16(fav[ks], fbl[ks], accl); }
            acc = acc + accl * (1.f / LO_SCALE);
            const int i = 16 * Ti + m; const float Gi = SG[i]; float v[4];
#pragma unroll
            for (int r = 0; r < 4; ++r) { const int j = 16 * Tj + 4 * q + r; v[r] = (i >= j) ? acc[r] * (128.f * __expf(Gi - SG[j])) : 0.f; }
            u32x2 w; w.x = pk2(v[0], v[1]); w.y = pk2(v[2], v[3]);
            *(u32x2*)(att + i * 64 + 16 * Tj + 4 * q) = w;
        }
        const int nk = wave < 2 ? 0 : (wave < 6 ? 2 : 1), k0 = wave < 6 ? 2 * (wave - 2) : 8 + (wave - 6);
        for (int jk = 0; jk < nk; ++jk) {
            const int kk = k0 + jk;
            const int Ti = kk < 1 ? 0 : (kk < 3 ? 1 : (kk < 6 ? 2 : 3)), Tj = kk - (Ti == 0 ? 0 : (Ti == 1 ? 1 : (Ti == 2 ? 3 : 6)));
            f32x4 acc = {0.f, 0.f, 0.f, 0.f};
            bf16x8 fa[4], fb[4];
#pragma unroll
            for (int ks = 0; ks < 4; ++ks) { fa[ks] = *(const bf16x8*)(KS + (16 * Ti + m) * 136 + 32 * ks + 8 * q); fb[ks] = *(const bf16x8*)(KS + (16 * Tj + m) * 136 + 32 * ks + 8 * q); }
            SCHED_FENCE();
#pragma unroll
            for (int ks = 0; ks < 4; ++ks) acc = mfma16(fa[ks], fb[ks], acc);
            const int j = 16 * Tj + m; const float Gj = SG[j];
#pragma unroll
            for (int r = 0; r < 4; ++r) { const int i = 16 * Ti + 4 * q + r; AF[i * 68 + j] = (i > j) ? SG[64 + i] * acc[r] * __expf(SG[i] - Gj) : 0.f; }
        }
        if (wave >= 6) {
            for (int jz = 0; jz < 3; ++jz) {
                const int z = 3 * (wave - 6) + jz;
                const int Tj = z < 1 ? 1 : (z < 3 ? 2 : 3), Ti = z - (Tj == 1 ? 0 : (Tj == 2 ? 1 : 3));
                *(u32x2*)(att + (16 * Ti + m) * 64 + 16 * Tj + 4 * q) = (u32x2){0u, 0u};
            }
        }
    }
    lds_barrier();
    {
        bf16_t* kdt = (bf16_t*)(ws + WS_KDT) + (size_t)task * 8192;
        for (int idx = tid; idx < 1024; idx += 512) { const int row = idx >> 3, ch = idx & 7; *(u32x4*)(kdt + row * 64 + 8 * ch) = *(const u32x4*)(KD + row * 72 + 8 * (ch ^ ((row >> 3) & 7))); }
        if (tid == 0) ((float*)(ws + WS_EGL))[task] = expf(SG[63]);
        int vz; asm volatile("v_mov_b32 %0, 0" : "=v"(vz));
        const float* AFv = AF + vz;
        float* TL = (float*)(lds + L_QS);
        float* OFF = (float*)(lds + L_KS);
        float* DINV = (float*)(lds + L_KS + 4096);
        if (wave == 0) {
            const int I = lane >> 4, c = lane & 15;
            const float* Ad = AF + (16 * I) * 68 + 16 * I;
            float d[16];
#pragma unroll
            for (int r = 0; r < 16; ++r) {
                float acc = (r == c) ? 1.f : 0.f;
#pragma unroll
                for (int r4 = 0; r4 < (r + 3) / 4; ++r4) {
                    const f32x4 av = *(const f32x4*)(Ad + r * 68 + 4 * r4);
                    if (4 * r4 + 0 < r) acc -= av[0] * d[4 * r4 + 0];
                    if (4 * r4 + 1 < r) acc -= av[1] * d[4 * r4 + 1];
                    if (4 * r4 + 2 < r) acc -= av[2] * d[4 * r4 + 2];
                    if (4 * r4 + 3 < r) acc -= av[3] * d[4 * r4 + 3];
                }
                d[r] = acc;
                DINV[(I * 16 + r) * 16 + c] = acc;
            }
        }
        lds_barrier();
#pragma unroll 1
        for (int I = 0; I < 4; ++I) {
            {
                const int r0 = 16 * I + 2 * wave;
                float s0 = (r0 == lane) ? 1.f : 0.f, s1 = (r0 + 1 == lane) ? 1.f : 0.f;
#pragma unroll 4
                for (int j = 0; j < 16 * I; j += 4) {
                    const float t0 = TL[(j + 0) * 64 + lane], t1 = TL[(j + 1) * 64 + lane], t2 = TL[(j + 2) * 64 + lane], t3 = TL[(j + 3) * 64 + lane];
                    const f32x4 a0 = *(const f32x4*)(AFv + r0 * 68 + j), a1 = *(const f32x4*)(AFv + (r0 + 1) * 68 + j);
                    s0 -= (a0[0] * t0 + a0[1] * t1) + (a0[2] * t2 + a0[3] * t3);
                    s1 -= (a1[0] * t0 + a1[1] * t1) + (a1[2] * t2 + a1[3] * t3);
                }
                OFF[(2 * wave) * 64 + lane] = s0; OFF[(2 * wave + 1) * 64 + lane] = s1;
            }
            lds_barrier();
            {
                const float* Dv = DINV + vz + (I * 16 + 2 * wave) * 16;
                float x[16];
#pragma unroll
                for (int r2 = 0; r2 < 16; ++r2) x[r2] = OFF[r2 * 64 + lane];
                float ta = 0.f, tb = 0.f;
#pragma unroll
                for (int r4 = 0; r4 < 4; ++r4) {
                    const f32x4 da = *(const f32x4*)(Dv + 4 * r4), db = *(const f32x4*)(Dv + 16 + 4 * r4);
                    ta += (da[0] * x[4 * r4] + da[1] * x[4 * r4 + 1]) + (da[2] * x[4 * r4 + 2] + da[3] * x[4 * r4 + 3]);
                    tb += (db[0] * x[4 * r4] + db[1] * x[4 * r4 + 1]) + (db[2] * x[4 * r4 + 2] + db[3] * x[4 * r4 + 3]);
                }
                const int ra = 16 * I + 2 * wave;
                TL[ra * 64 + lane] = ta; TL[(ra + 1) * 64 + lane] = tb;
                TB[ra * 72 + lane] = (bf16_t)f2bf(ta); TB[(ra + 1) * 72 + lane] = (bf16_t)f2bf(tb);
            }
            lds_barrier();
        }
    }
    {
        bf16_t* ut = (bf16_t*)(ws + WS_UT) + (size_t)task * 8192;
        {
            const int swb = (2 * wave + (m >> 3)) & 7;
            bf16x8 bv[2], fa[8];
#pragma unroll
            for (int s = 0; s < 2; ++s) bv[s] = *(const bf16x8*)(RT + (16 * wave + m) * 72 + 8 * ((4 * s + q) ^ swb));
#pragma unroll
            for (int i = 0; i < 8; ++i) { const int P = i >> 2, s = (i >> 1) & 1, t = i & 1; fa[i] = *(const bf16x8*)(TB + (32 * P + il(t, m)) * 72 + 32 * s + 8 * q); }
            SCHED_FENCE();
#pragma unroll
            for (int P = 0; P < 2; ++P) {
                f32x4 c0 = {0.f, 0.f, 0.f, 0.f}, c1 = {0.f, 0.f, 0.f, 0.f};
#pragma unroll
                for (int s = 0; s < 2; ++s) { c0 = mfma16(fa[4 * P + 2 * s], bv[s], c0); c1 = mfma16(fa[4 * P + 2 * s + 1], bv[s], c1); }
                *(bf16x8*)(ut + (16 * wave + m) * 64 + 32 * P + 8 * q) = pack8(c0, c1);
            }
        }
        bf16_t* nw = (bf16_t*)(ws + WS_NEGW) + (size_t)task * 8192;
        {
            const int Pd = wave >> 1, swa = (4 * Pd + (m >> 2)) & 7;
            bf16x8 fb[4], fa[4];
#pragma unroll
            for (int i = 0; i < 4; ++i) { const int tt = i >> 1, s = i & 1; fb[i] = *(const bf16x8*)(TB + (16 * (2 * (wave & 1) + tt) + m) * 72 + 32 * s + 8 * q); }
#pragma unroll
            for (int i = 0; i < 4; ++i) { const int s = i >> 1, t = i & 1; fa[i] = *(const bf16x8*)(RT + (128 + 32 * Pd + il(t, m)) * 72 + 8 * ((4 * s + q) ^ swa)); }
            SCHED_FENCE();
#pragma unroll
            for (int tt = 0; tt < 2; ++tt) {
                const int Ti = 2 * (wave & 1) + tt;
                f32x4 c0 = {0.f, 0.f, 0.f, 0.f}, c1 = {0.f, 0.f, 0.f, 0.f};
#pragma unroll
                for (int s = 0; s < 2; ++s) { c0 = mfma16(fa[2 * s], fb[2 * tt + s], c0); c1 = mfma16(fa[2 * s + 1], fb[2 * tt + s], c1); }
                *(bf16x8*)(nw + (16 * Ti + m) * 128 + 32 * Pd + 8 * q) = pack8(-c0, -c1);
            }
        }
    }
    lds_barrier();
}

constexpr int G_QS = 0, G_KS = 9216, G_KDT = 18432, G_VT = 27648, G_TOT = 46080, G_GR = 48128, G_W2 = 52224;
__device__ __forceinline__ void gla_prep(const Args& a, int l, int task, unsigned char* lds) {
    const int tid = otid(), lane = tid & 63, wave = __builtin_amdgcn_readfirstlane(tid >> 6), m = lane & 15, q = lane >> 4;
    const int bh = task >> 5, n = task & 31, b = bh >> 2, h = bh & 3;
    unsigned char* ws = a.ws;
    bf16_t* QS = (bf16_t*)(lds + G_QS); bf16_t* KS = (bf16_t*)(lds + G_KS); bf16_t* KDT = (bf16_t*)(lds + G_KDT); bf16_t* VT = (bf16_t*)(lds + G_VT);
    float* TOT = (float*)(lds + G_TOT);
    const size_t tok0 = (size_t)b * SEQ + 64 * n;
    const int d = lane, tg = wave;
    float* GR = (float*)(lds + G_GR);
    f32x4 grv;
    if (tid < 256) grv = *(const f32x4*)((const float*)(ws + WS_SMALL) + (tok0 + (tid >> 2)) * 32 + 8 + 4 * (tid & 3));
    float c[8];
    bf16_t qraw[8], kraw[8];
    {
        const bf16_t* qp = (const bf16_t*)(ws + WS_GQ) + (tok0 + 8 * tg) * 256 + 64 * h + d;
        const bf16_t* kp = (const bf16_t*)(ws + WS_GK) + (tok0 + 8 * tg) * 256 + 64 * h + d;
#pragma unroll
        for (int tt = 0; tt < 8; ++tt) { qraw[tt] = qp[tt * 256]; kraw[tt] = kp[tt * 256]; }
    }
    const int vt = tid >> 3, vc2 = tid & 7;
    const bf16_t* vp = (const bf16_t*)(ws + WS_GV) + (tok0 + vt) * 512 + 128 * h + 16 * vc2;
    const u32x4 vw0 = *(const u32x4*)vp, vw1 = *(const u32x4*)(vp + 8);
    if (tid < 256) *(f32x4*)(GR + (tid >> 2) * 16 + 4 * (tid & 3)) = grv;
    lds_barrier();
    {
        float w2[16];
        const float* W2L = (const float*)(lds + G_W2);
#pragma unroll
        for (int r = 0; r < 16; ++r) w2[r] = W2L[r * 64 + d];
        const float bias = W2L[1024 + d];
        float run = 0.f;
#pragma unroll
        for (int tt = 0; tt < 8; ++tt) {
            const float* gr = GR + (8 * tg + tt) * 16;
            float lg = bias;
#pragma unroll
            for (int r4 = 0; r4 < 4; ++r4) { const f32x4 gv = *(const f32x4*)(gr + 4 * r4); lg += gv[0] * w2[4 * r4] + gv[1] * w2[4 * r4 + 1] + gv[2] * w2[4 * r4 + 2] + gv[3] * w2[4 * r4 + 3]; }
            const float lf = (fminf(lg, 0.f) - __logf(1.f + __expf(-fabsf(lg)))) * 0.0625f;
            run += lf; c[tt] = run;
        }
        TOT[tg * 64 + d] = run;
    }
    {
        const int t = vt, c2 = vc2;
        const unsigned ww[8] = {vw0.x, vw0.y, vw0.z, vw0.w, vw1.x, vw1.y, vw1.z, vw1.w};
#pragma unroll
        for (int e = 0; e < 8; ++e) { VT[(16 * c2 + 2 * e) * 72 + t] = (bf16_t)(ww[e] & 0xffffu); VT[(16 * c2 + 2 * e + 1) * 72 + t] = (bf16_t)(ww[e] >> 16); }
    }
    lds_barrier();
    {
        float pre = 0.f, Bl = 0.f;
#pragma unroll
        for (int g = 0; g < 8; ++g) { const float tv = TOT[g * 64 + d]; if (g < tg) pre += tv; Bl += tv; }
        bf16_t* qt = (bf16_t*)(ws + WS_GQT) + (size_t)task * 4096;
        float kd[8];
#pragma unroll
        for (int tt = 0; tt < 8; ++tt) {
            const float Bv = c[tt] + pre; const int t = 8 * tg + tt;
            const float Rh = 0.5f * Bl;
            const float qv = h1f(qraw[tt]) * 0.125f * __expf(fminf(fmaxf(Bv - Rh, -9.5f), 9.5f)), kv = h1f(kraw[tt]);
            const bf16_t qb = (bf16_t)f2bf(qv);
            QS[t * 72 + d] = qb; qt[t * 64 + d] = qb;
            KS[t * 72 + d] = (bf16_t)f2bf(kv * __expf(fmaxf(fminf(Rh - Bv, 9.5f), -9.5f)));
            kd[tt] = kv * __expf(Bl - Bv);
        }
        u32x4 w; w.x = pk2(kd[0], kd[1]); w.y = pk2(kd[2], kd[3]); w.z = pk2(kd[4], kd[5]); w.w = pk2(kd[6], kd[7]);
        *(u32x4*)(KDT + d * 72 + 8 * tg) = w;
        if (tg == 0) ((float*)(ws + WS_EBL))[(size_t)task * 64 + d] = expf(Bl);
    }
    lds_barrier();
    {
        bf16_t* vt = (bf16_t*)(ws + WS_GVT) + (size_t)task * 8192;
        for (int idx = tid; idx < 1024; idx += 512) { const int row = idx >> 3, ch = idx & 7; *(u32x4*)(vt + row * 64 + 8 * ch) = *(const u32x4*)(VT + row * 72 + 8 * ch); }
    }
    {
        bf16_t* att = (bf16_t*)(ws + WS_GATT) + (size_t)task * 4096;
#pragma unroll
        for (int tt = 0; tt < 2; ++tt) {
            const int tile = 2 * wave + tt, Tj = tile >> 2, Ti = tile & 3;
            f32x4 acc = {0.f, 0.f, 0.f, 0.f};
            if (Ti >= Tj) {
#pragma unroll
                for (int ks = 0; ks < 2; ++ks) {
                    const bf16x8 av = *(const bf16x8*)(KS + (16 * Tj + m) * 72 + 32 * ks + 8 * q), bv = *(const bf16x8*)(QS + (16 * Ti + m) * 72 + 32 * ks + 8 * q);
                    acc = mfma16(av, bv, acc);
                }
            }
            const int i = 16 * Ti + m; float v[4];
#pragma unroll
            for (int r = 0; r < 4; ++r) { const int j = 16 * Tj + 4 * q + r; v[r] = (i >= j) ? acc[r] : 0.f; }
            u32x2 w; w.x = pk2(v[0], v[1]); w.y = pk2(v[2], v[3]);
            *(u32x2*)(att + i * 64 + 16 * Tj + 4 * q) = w;
        }
    }
    {
        bf16_t* st = (bf16_t*)(ws + WS_GST) + (size_t)task * 8192;
#pragma unroll
        for (int Tk = 0; Tk < 4; ++Tk) {
            f32x4 acc = {0.f, 0.f, 0.f, 0.f};
#pragma unroll
            for (int s = 0; s < 2; ++s) {
                const bf16x8 av = *(const bf16x8*)(KDT + (16 * Tk + m) * 72 + 32 * s + 8 * q), bv = *(const bf16x8*)(VT + (16 * wave + m) * 72 + 32 * s + 8 * q);
                acc = mfma16(av, bv, acc);
            }
            u32x2 w; w.x = pk2(acc[0], acc[1]); w.y = pk2(acc[2], acc[3]);
            *(u32x2*)(st + (16 * wave + m) * 64 + 16 * Tk + 4 * q) = w;
        }
    }
    lds_barrier();
}

constexpr int SC_NW = 0, SC_KD = 17408, SC_BUF = 35840;
struct ScanSet { u32x4 pw[2], pk[2], pu[2]; };
__device__ __forceinline__ void scan_load(unsigned char* ws, size_t task, int tid, int w, int m, int q, ScanSet& s) {
    const bf16_t* negW = (const bf16_t*)(ws + WS_NEGW) + task * 8192; const bf16_t* kdT = (const bf16_t*)(ws + WS_KDT) + task * 8192; const bf16_t* uT = (const bf16_t*)(ws + WS_UT) + task * 8192;
#pragma unroll
    for (int i = 0; i < 2; ++i) { const int idx = tid + 512 * i; s.pw[i] = *(const u32x4*)(negW + idx * 8); s.pk[i] = *(const u32x4*)(kdT + idx * 8); s.pu[i] = *(const u32x4*)(uT + (16 * w + m) * 64 + 32 * i + 8 * q); }
}
__device__ __forceinline__ void scan_stage(unsigned char* buf, int tid, const ScanSet& s) {
#pragma unroll
    for (int i = 0; i < 2; ++i) { const int idx = tid + 512 * i;
        *(u32x4*)(buf + SC_NW + ((idx >> 4) * 136 + (((idx & 15) ^ (((idx >> 8) & 1) << 2)) * 8)) * 2) = s.pw[i];
        *(u32x4*)(buf + SC_KD + ((idx >> 3) * 72 + (((idx & 7) ^ (((idx >> 7) & 1) << 2)) * 8)) * 2) = s.pk[i]; }
}
__device__ __forceinline__ void dn_scan(const Args& a, int bh, int half, unsigned char* lds) {
    const int tid = otid(), lane = tid & 63, wv = __builtin_amdgcn_readfirstlane(tid >> 6), w = 4 * half + (wv & 3), m = lane & 15, q = lane >> 4;
    const bool active = wv < 4;
    unsigned char* ws = a.ws;
    f32x4 S[8];
#pragma unroll
    for (int i = 0; i < 8; ++i) S[i] = (f32x4){0.f, 0.f, 0.f, 0.f};
    const float eglv = ((const float*)(ws + WS_EGL))[(size_t)bh * 32 + (lane & 31)];
    ScanSet A, B; u32x4 cu0, cu1;
    { ScanSet t0; scan_load(ws, (size_t)bh * 32, tid, w, m, q, t0); scan_load(ws, (size_t)bh * 32 + 1, tid, w, m, q, B); scan_stage(lds, tid, t0); cu0 = t0.pu[0]; cu1 = t0.pu[1]; }
    __syncthreads();
#define SCAN_STEP(n, ISSUE, STAGE) do { \
        const size_t task = (size_t)bh * 32 + (n); \
        unsigned char* buf = lds + ((n) & 1) * SC_BUF; \
        const bf16_t* NW = (const bf16_t*)(buf + SC_NW); const bf16_t* KD = (const bf16_t*)(buf + SC_KD); \
        bf16_t* uT = (bf16_t*)(ws + WS_UT) + task * 8192; bf16_t* ST = (bf16_t*)(ws + WS_DNST) + task * 16384; \
        const float egl = __shfl(eglv, (n)); \
        if ((n) + 2 < 32) scan_load(ws, task + 2, tid, w, m, q, ISSUE); \
        if (active) { \
        bf16x8 Sb[4], Vb[2]; \
        _Pragma("unroll") for (int ks = 0; ks < 4; ++ks) { Sb[ks] = pack8(S[2 * ks], S[2 * ks + 1]); *(bf16x8*)(ST + (16 * w + m) * 128 + 32 * ks + 8 * q) = Sb[ks]; } \
        bf16x8 fa[8], fb[8]; \
        _Pragma("unroll") for (int i = 0; i < 8; ++i) { const int ks = i >> 1, t = i & 1; fa[i] = *(const bf16x8*)(NW + il(t, m) * 136 + ((4 * ks + q) ^ ((m >> 3) << 2)) * 8); } \
        SCHED_FENCE(); \
        f32x4 v0 = {bflo(cu0.x), bfhi(cu0.x), bflo(cu0.y), bfhi(cu0.y)}, v1 = {bflo(cu0.z), bfhi(cu0.z), bflo(cu0.w), bfhi(cu0.w)}; \
        _Pragma("unroll") for (int ks = 0; ks < 4; ++ks) { v0 = mfma16(fa[2 * ks], Sb[ks], v0); v1 = mfma16(fa[2 * ks + 1], Sb[ks], v1); } \
        _Pragma("unroll") for (int i = 0; i < 8; ++i) { const int ks = i >> 1, t = i & 1; fb[i] = *(const bf16x8*)(NW + (32 + il(t, m)) * 136 + ((4 * ks + q) ^ ((m >> 3) << 2)) * 8); } \
        SCHED_FENCE(); \
        Vb[0] = pack8(v0, v1); \
        *(bf16x8*)(uT + (16 * w + m) * 64 + 8 * q) = Vb[0]; \
        v0 = (f32x4){bflo(cu1.x), bfhi(cu1.x), bflo(cu1.y), bfhi(cu1.y)}; v1 = (f32x4){bflo(cu1.z), bfhi(cu1.z), bflo(cu1.w), bfhi(cu1.w)}; \
        _Pragma("unroll") for (int ks = 0; ks < 4; ++ks) { v0 = mfma16(fb[2 * ks], Sb[ks], v0); v1 = mfma16(fb[2 * ks + 1], Sb[ks], v1); } \
        _Pragma("unroll") for (int i = 0; i < 8; ++i) { const int Pd = i >> 2, t = (i >> 1) & 1, s = i & 1; fa[i] = *(const bf16x8*)(KD + (32 * Pd + il(t, m)) * 72 + ((4 * s + q) ^ ((m >> 3) << 2)) * 8); } \
        SCHED_FENCE(); \
        Vb[1] = pack8(v0, v1); \
        *(bf16x8*)(uT + (16 * w + m) * 64 + 32 + 8 * q) = Vb[1]; \
        _Pragma("unroll") for (int i = 0; i < 8; i += 2) { const int Pd = i >> 2, t = (i >> 1) & 1; \
            f32x4 acc = S[2 * Pd + t] * egl; acc = mfma16(fa[i], Vb[0], acc); acc = mfma16(fa[i + 1], Vb[1], acc); S[2 * Pd + t] = acc; } \
        _Pragma("unroll") for (int i = 0; i < 8; ++i) { const int Pd = 2 + (i >> 2), t = (i >> 1) & 1, s = i & 1; fb[i] = *(const bf16x8*)(KD + (32 * Pd + il(t, m)) * 72 + ((4 * s + q) ^ ((m >> 3) << 2)) * 8); } \
        SCHED_FENCE(); \
        _Pragma("unroll") for (int i = 0; i < 8; i += 2) { const int Pd = 2 + (i >> 2), t = (i >> 1) & 1; \
            f32x4 acc = S[2 * Pd + t] * egl; acc = mfma16(fb[i], Vb[0], acc); acc = mfma16(fb[i + 1], Vb[1], acc); S[2 * Pd + t] = acc; } \
        SCHED_FENCE(); } \
        if ((n) + 1 < 32) { scan_stage(lds + (((n) + 1) & 1) * SC_BUF, tid, STAGE); cu0 = STAGE.pu[0]; cu1 = STAGE.pu[1]; } \
        lds_barrier(); } while (0)
#pragma unroll 1
    for (int n = 0; n < 32; n += 2) { SCAN_STEP(n, A, B); SCAN_STEP(n + 1, B, A); }
#undef SCAN_STEP
}
__device__ __forceinline__ void gla_prefix(const Args& a, int vb, int nvb) {
    unsigned char* ws = a.ws;
    for (int item = vb * 512 + otid(); item < 32768; item += nvb * 512) {
        const int bh = item >> 10, dv = (item >> 3) & 127, kg = item & 7;
        float S[8];
#pragma unroll
        for (int e = 0; e < 8; ++e) S[e] = 0.f;
        for (int n0 = 0; n0 < 32; n0 += 8) {
            u32x4 dw[8]; f32x4 e0[8], e1[8];
#pragma unroll
            for (int j = 0; j < 8; ++j) {
                const size_t task = (size_t)bh * 32 + n0 + j;
                dw[j] = *(const u32x4*)((const bf16_t*)(ws + WS_GST) + task * 8192 + dv * 64 + 8 * kg);
                const float* eb = (const float*)(ws + WS_EBL) + task * 64 + 8 * kg;
                e0[j] = *(const f32x4*)eb; e1[j] = *(const f32x4*)(eb + 4);
            }
#pragma unroll
            for (int j = 0; j < 8; ++j) {
                const size_t task = (size_t)bh * 32 + n0 + j;
                const f32x4 r0 = {sqrtf(e0[j][0]), sqrtf(e0[j][1]), sqrtf(e0[j][2]), sqrtf(e0[j][3])}, r1 = {sqrtf(e1[j][0]), sqrtf(e1[j][1]), sqrtf(e1[j][2]), sqrtf(e1[j][3])};
                u32x4 o; o.x = pk2(S[0] * r0[0], S[1] * r0[1]); o.y = pk2(S[2] * r0[2], S[3] * r0[3]); o.z = pk2(S[4] * r1[0], S[5] * r1[1]); o.w = pk2(S[6] * r1[2], S[7] * r1[3]);
                *(u32x4*)((bf16_t*)(ws + WS_GST) + task * 8192 + dv * 64 + 8 * kg) = o;
                float dS[8]; unpack8(dw[j], dS);
                S[0] = S[0] * e0[j][0] + dS[0]; S[1] = S[1] * e0[j][1] + dS[1]; S[2] = S[2] * e0[j][2] + dS[2]; S[3] = S[3] * e0[j][3] + dS[3];
                S[4] = S[4] * e1[j][0] + dS[4]; S[5] = S[5] * e1[j][1] + dS[5]; S[6] = S[6] * e1[j][2] + dS[6]; S[7] = S[7] * e1[j][3] + dS[7];
            }
        }
    }
}

template <int DK>
__device__ __forceinline__ void out_phase(const Args& a, int l, bool gla, int first, int stride, unsigned char* lds) {
    const int tid = otid(), lane = tid & 63, w = __builtin_amdgcn_readfirstlane(tid >> 6), m = lane & 15, q = lane >> 4;
    unsigned char* ws = a.ws;
    constexpr int QP = DK + 8, NQ = 64 * DK / 8 / 512;
    constexpr int B_AT = 64 * QP * 2, B_SZ = B_AT + 64 * 72 * 2, O_RED = 2 * B_SZ;
    const float oscale = gla ? 1.f : (1.f / 128.f);
    const bf16_t* STb = (const bf16_t*)(ws + (gla ? WS_GST : WS_DNST)); const bf16_t* QTb = (const bf16_t*)(ws + (gla ? WS_GQT : WS_DQT));
    const bf16_t* VTb = (const bf16_t*)(ws + (gla ? WS_GVT : WS_UT)); const bf16_t* ATb = (const bf16_t*)(ws + (gla ? WS_GATT : WS_DATT));
    const bf16_t* Z = (const bf16_t*)(ws + (gla ? WS_GZ : WS_DNZ));
    bf16_t* O = (bf16_t*)(ws + WS_O);
    const f32x4 gv = *(const f32x4*)((gla ? a.gla_g : a.dn_g) + l * 128 + 16 * w + 4 * q);
    u32x4 pq[NQ], pa, pS[DK / 32], pV[2]; u32x2 pz[4];
    if (first >= NTASK) return;
#define OUT_LOAD(task) do { const size_t _t = (size_t)(task); const int _bh = (task) >> 5, _n = (task) & 31; const size_t _tok0 = (size_t)(_bh >> 2) * SEQ + 64 * _n; \
        _Pragma("unroll") for (int i = 0; i < NQ; ++i) pq[i] = *(const u32x4*)(QTb + _t * (64 * DK) + (tid + 512 * i) * 8); \
        pa = *(const u32x4*)(ATb + _t * 4096 + tid * 8); \
        _Pragma("unroll") for (int ks = 0; ks < DK / 32; ++ks) pS[ks] = *(const u32x4*)(STb + _t * (128 * DK) + (16 * w + m) * DK + 32 * ks + 8 * q); \
        _Pragma("unroll") for (int s = 0; s < 2; ++s) pV[s] = *(const u32x4*)(VTb + _t * 8192 + (16 * w + m) * 64 + 32 * s + 8 * q); \
        _Pragma("unroll") for (int Ti = 0; Ti < 4; ++Ti) pz[Ti] = *(const u32x2*)(Z + (_tok0 + 16 * Ti + m) * 512 + 128 * (_bh & 3) + 16 * w + 4 * q); } while (0)
#define OUT_STAGE(buf) do { unsigned char* _b = lds + (buf) * B_SZ; \
        _Pragma("unroll") for (int i = 0; i < NQ; ++i) { const int idx = tid + 512 * i; *(u32x4*)(_b + ((idx / (DK / 8)) * QP + (idx % (DK / 8)) * 8) * 2) = pq[i]; } \
        *(u32x4*)(_b + B_AT + ((tid >> 3) * 72 + (tid & 7) * 8) * 2) = pa; } while (0)
    OUT_LOAD(first);
    OUT_STAGE(0);
    __syncthreads();
    int it = 0;
    for (int task = first; task < NTASK; task += stride, ++it) {
        const int bh = task >> 5, n = task & 31, h = bh & 3;
        const size_t tok0 = (size_t)(bh >> 2) * SEQ + 64 * n;
        u32x4 cS[DK / 32], cV[2]; u32x2 cz[4];
#pragma unroll
        for (int ks = 0; ks < DK / 32; ++ks) cS[ks] = pS[ks];
        cV[0] = pV[0]; cV[1] = pV[1];
#pragma unroll
        for (int Ti = 0; Ti < 4; ++Ti) cz[Ti] = pz[Ti];
        const bool more = task + stride < NTASK;
        if (more) OUT_LOAD(task + stride);
        const bf16_t* QS = (const bf16_t*)(lds + (it & 1) * B_SZ); const bf16_t* AS = (const bf16_t*)(lds + (it & 1) * B_SZ + B_AT);
        float* red = (float*)(lds + O_RED) + (it & 1) * 512;
        f32x4 acc[4];
#pragma unroll
        for (int Ti = 0; Ti < 4; ++Ti) acc[Ti] = (f32x4){0.f, 0.f, 0.f, 0.f};
#pragma unroll
        for (int ks = 0; ks < DK / 32; ks += 2) {
            bf16x8 fb[8];
#pragma unroll
            for (int i = 0; i < 8; ++i) fb[i] = *(const bf16x8*)(QS + (16 * (i & 3) + m) * QP + 32 * (ks + (i >> 2)) + 8 * q);
            SCHED_FENCE();
#pragma unroll
            for (int i = 0; i < 8; ++i) acc[i & 3] = mfma16(__builtin_bit_cast(bf16x8, cS[ks + (i >> 2)]), fb[i], acc[i & 3]);
            SCHED_FENCE();
        }
        {
            bf16x8 fb[8];
#pragma unroll
            for (int i = 0; i < 8; ++i) fb[i] = *(const bf16x8*)(AS + (16 * (i & 3) + m) * 72 + 32 * (i >> 2) + 8 * q);
            SCHED_FENCE();
#pragma unroll
            for (int i = 0; i < 8; ++i) acc[i & 3] = mfma16(__builtin_bit_cast(bf16x8, cV[i >> 2]), fb[i], acc[i & 3]);
            SCHED_FENCE();
        }
#pragma unroll
        for (int Ti = 0; Ti < 4; ++Ti) {
            acc[Ti] = acc[Ti] * oscale;
            float ss = acc[Ti][0] * acc[Ti][0] + acc[Ti][1] * acc[Ti][1] + acc[Ti][2] * acc[Ti][2] + acc[Ti][3] * acc[Ti][3];
            ss += __shfl_xor(ss, 16); ss += __shfl_xor(ss, 32);
            if (q == 0) red[w * 64 + 16 * Ti + m] = ss;
        }
        if (more) OUT_STAGE((it + 1) & 1);
        lds_barrier();
#pragma unroll
        for (int Ti = 0; Ti < 4; ++Ti) {
            const int t = 16 * Ti + m;
            float tot = 0.f;
#pragma unroll
            for (int ww = 0; ww < 8; ++ww) tot += red[ww * 64 + t];
            const float rstd = rsqrtf(tot * (1.f / 128.f) + EPS);
            const float z0 = hlo(cz[Ti].x), z1 = hhi(cz[Ti].x), z2 = hlo(cz[Ti].y), z3 = hhi(cz[Ti].y);
            u32x2 o; o.x = pkh2(acc[Ti][0] * rstd * gv[0] * siluf(z0), acc[Ti][1] * rstd * gv[1] * siluf(z1));
            o.y = pkh2(acc[Ti][2] * rstd * gv[2] * siluf(z2), acc[Ti][3] * rstd * gv[3] * siluf(z3));
            *(u32x2*)(O + (tok0 + t) * 1024 + (gla ? 512 : 0) + 128 * h + 16 * w + 4 * q) = o;
        }
    }
    __syncthreads();
#undef OUT_LOAD
#undef OUT_STAGE
}

constexpr int LDS_BYTES = 152064 + 6144 + 16;
__global__ void __launch_bounds__(512, 2) mk_fwd(Args a) {
    extern __shared__ __attribute__((aligned(16))) unsigned char lds[];
    cg::grid_group grid = cg::this_grid();
    const int G = gridDim.x, bid = blockIdx.x;
    const int dn0 = (G == 256) ? 32 * (bid & 7) + (bid >> 3) : bid;
    int ph = 0;
#define PHASE_BEGIN if (ph >= a.ph_lo && ph < a.ph_hi) {
#define PHASE_END   if (ph + 1 < a.ph_hi) { \
        xcd_barrier(xbar); } \
    } ++ph;
    volatile LAS unsigned* bst = (volatile LAS unsigned*)((LAS unsigned char*)lds + LDS_BYTES - 16);
    if (threadIdx.x < 4) bst[threadIdx.x] = 0u;
    __syncthreads();
    const XcdBarrier xbar = xcd_barrier_post((unsigned*)(a.ws + WS_BAR), bst);
    if (a.ph_hi > 4096) grid.sync();
    PHASE_BEGIN prologue(a, lds); PHASE_END
    for (int l = 0; l < 2; ++l) {
        const float* resid = l == 0 ? a.x : a.out;
        PHASE_BEGIN {
            pg8::Gemm g{(const bf16_t*)(a.ws + WS_XB), (const bf16_t*)(a.ws + WS_WIN + l * WIN_BYTES), MROWS, NPROJ, DM};
            pg8::StaticOrder S; S.init(MROWS, NPROJ, G, bid); EpiProj E{a.ws};
            pg8::gemm_phase<EpiProj>((LAS unsigned char*)lds, g, S, E);
        } PHASE_END
        PHASE_BEGIN
            { DnPre P; if (dn0 < NTASK) dn_preload(a, dn0, otid(), P);
              int hs = -1; float dtb = 0.f, nexpa = 0.f;
              for (int t = dn0; t < NTASK; t += G) {
                  const int h = (t >> 5) & 3;
                  if (h != hs) {
                      const int tt = otid();
                      if (tt < 384) { const int X = tt >> 7, r = tt & 127, tap = r >> 5, c4 = r & 31;
                          const float sc = X < 2 ? (1.f / 4096.f) : 1.f;
                          *(f32x4*)((float*)(lds + L_CW) + X * 512 + tap * 128 + 4 * c4) = *(const f32x4*)(a.conv_w + (size_t)l * 4 * 1536 + tap * 1536 + X * 512 + 128 * h + 4 * c4) * sc; }
                      dtb = a.dt_bias[l * 4 + h]; nexpa = -__expf(a.a_log[l * 4 + h]);
                      hs = h; lds_barrier();
                  }
                  dn_prep(a, l, t, t + G < NTASK ? t + G : -1, P, dtb, nexpa, lds);
              } }
            { int hs = -1;
              for (int t = bid; t < NTASK; t += G) {
                  const int h = (t >> 5) & 3;
                  if (h != hs) {
                      const int tt = otid(); float* W2L = (float*)(lds + G_W2);
                      for (int i = tt; i < 1088; i += 512) W2L[i] = i < 1024 ? a.gw2[(size_t)l * 16 * 256 + (i >> 6) * 256 + 64 * h + (i & 63)] : a.gb[l * 256 + 64 * h + (i - 1024)];
                      hs = h; lds_barrier();
                  }
                  gla_prep(a, l, t, lds);
              } }
        PHASE_END
        PHASE_BEGIN
            if (bid < 64) dn_scan(a, (bid & 7) + 8 * (bid >> 4), (bid >> 3) & 1, lds);
            else {
                unsigned* cnt = (unsigned*)(a.ws + WS_CNT) + 64 * l;
                const int vb = bid - 64, nvb = G - 64, nprod = nvb < 64 ? nvb : 64;
                gla_prefix(a, vb, nvb);
                asm volatile("s_waitcnt vmcnt(0)" ::: "memory");
                __syncthreads();
                if (threadIdx.x == 0) {
                    if (vb < nprod) { __builtin_amdgcn_fence(__ATOMIC_RELEASE, "agent"); asm volatile("s_waitcnt vmcnt(0)" ::: "memory"); (void)xb_add(cnt, 1u); }
                    unsigned sp = 0;
                    while (xb_ld(cnt) < (unsigned)nprod) { __builtin_amdgcn_s_sleep(4); if (++sp > (1u << 24)) break; }
                    __builtin_amdgcn_fence(__ATOMIC_ACQUIRE, "agent"); asm volatile("s_waitcnt vmcnt(0)" ::: "memory");
                }
                __syncthreads();
                out_phase<64>(a, l, true, vb, nvb, lds);
                if (l == 0) { const int tt = otid(); convert_weights(a, 1, vb * 8 + (tt >> 6), nvb * 8, (float*)(lds + (tt >> 6) * 8448), tt & 63); }
            }
        PHASE_END
        PHASE_BEGIN
            out_phase<128>(a, l, false, dn0, G, lds);
        PHASE_END
        PHASE_BEGIN {
            pg8::Gemm g{(const bf16_t*)(a.ws + WS_O), (const bf16_t*)(a.ws + WS_WOUT + l * WOUT_BYTES), MROWS, DM, DM};
            pg8::StaticOrder S; S.init(MROWS, DM, G, bid);
            EpiOutLN E{resid, a.out, l == 0 ? (bf16_t*)(a.ws + WS_XB) : nullptr, a.ln_g + l * DM, a.ln_b + l * DM, (unsigned*)(a.ws + WS_XBUF), (unsigned*)(a.ws + WS_LNCNT) + l * 4096};
            pg8::gemm_phase<EpiOutLN>((LAS unsigned char*)lds, g, S, E);
        } PHASE_END
    }
}
constexpr int NPHASE = 11;

extern "C" void kernel_launch(void* const* d_in, const int* in_sizes, int n_in, void* d_out, int out_size,
                              void* d_ws, size_t ws_size, hipStream_t stream) {
    static int grid = 0;
    if (grid == 0) {
        int dev = 0, cus = 0, per_cu = 0;
        (void)hipGetDevice(&dev);
        (void)hipDeviceGetAttribute(&cus, hipDeviceAttributeMultiprocessorCount, dev);
        (void)hipFuncSetAttribute((const void*)mk_fwd, hipFuncAttributeMaxDynamicSharedMemorySize, LDS_BYTES);
        (void)hipOccupancyMaxActiveBlocksPerMultiprocessor(&per_cu, (const void*)mk_fwd, 512, LDS_BYTES);
        if (per_cu < 1) { fprintf(stderr, "kernel_launch: occupancy query reports %d blocks per CU\n", per_cu); }
        grid = cus > 0 ? cus : 256;
        if (ws_size < WS_END) { fprintf(stderr, "kernel_launch: workspace too small: %zu < %zu\n", ws_size, (size_t)WS_END); grid = -1; }
    }
    if (grid < 0) return;
    Args a{};
    a.x = (const float*)d_in[0]; a.w_in = (const float*)d_in[1]; a.conv_w = (const float*)d_in[2]; a.a_log = (const float*)d_in[3];
    a.dt_bias = (const float*)d_in[4]; a.gw2 = (const float*)d_in[5]; a.gb = (const float*)d_in[6]; a.dn_g = (const float*)d_in[7];
    a.gla_g = (const float*)d_in[8]; a.w_out = (const float*)d_in[9]; a.ln_g = (const float*)d_in[10]; a.ln_b = (const float*)d_in[11];
    a.out = (float*)d_out; a.ws = (unsigned char*)d_ws;
#ifndef MK_LAUNCHES
#define MK_LAUNCHES 1
#endif
    (void)hipMemsetAsync((char*)d_ws + WS_BAR, 0, 65536, stream);
    for (int li = 0; li < MK_LAUNCHES; ++li) {
        a.ph_lo = MK_LAUNCHES == 1 ? 0 : li; a.ph_hi = MK_LAUNCHES == 1 ? NPHASE : li + 1;
        void* args[] = {&a};
        hipError_t e = hipLaunchCooperativeKernel((const void*)mk_fwd, dim3(grid), dim3(512), args, LDS_BYTES, stream);
        if (e != hipSuccess) { fprintf(stderr, "cooperative launch failed: %s\n", hipGetErrorString(e)); break; }
    }
}
```

```cpp
#include <hip/hip_runtime.h>
#include <hip/hip_cooperative_groups.h>
#include <cstdio>
namespace cg = cooperative_groups;

#define LAS __attribute__((address_space(3)))
typedef unsigned short bf16_t;
typedef short bf16x8 __attribute__((ext_vector_type(8)));
typedef float f32x4 __attribute__((ext_vector_type(4)));
typedef unsigned u32x4 __attribute__((ext_vector_type(4)));
typedef unsigned u32x2 __attribute__((ext_vector_type(2)));

constexpr int SEQ = 2048, DM = 1024, MROWS = 16384, NPROJ = 3840, NTASK = 1024;
constexpr float DEEP_ALPHA = 1.41421356237f, EPS = 1e-6f;
constexpr size_t MiB = 1u << 20;
constexpr size_t WS_EGL = 0, WS_EBL = 65536, WS_SMALL = 1 * MiB, WS_WIN = 3 * MiB, WS_WOUT = 18 * MiB, WS_XB = 22 * MiB;
constexpr size_t WS_NEGW = 22 * MiB, WS_KDT = 38 * MiB;
constexpr size_t WS_DNZ = 54 * MiB, WS_GZ = 70 * MiB;
constexpr size_t WS_DNQ = 86 * MiB, WS_DNK = 102 * MiB, WS_DNV = 118 * MiB, WS_GQ = 134 * MiB, WS_GK = 142 * MiB, WS_GV = 150 * MiB;
constexpr size_t WS_DNST = 86 * MiB;
constexpr size_t WS_UT = 166 * MiB, WS_DQT = 182 * MiB, WS_DATT = 198 * MiB, WS_GQT = 206 * MiB, WS_GATT = 214 * MiB, WS_GVT = 222 * MiB, WS_GST = 238 * MiB;
constexpr size_t WS_Y = 166 * MiB, WS_END = 255 * MiB;
constexpr size_t WS_O = 118 * MiB;
constexpr size_t WS_CNT = 540672, WS_LNCNT = 544768, WS_XBUF = 254 * MiB;
constexpr size_t WIN_BYTES = (size_t)NPROJ * DM * 2, WOUT_BYTES = (size_t)DM * DM * 2;

typedef _Float16 h16x2 __attribute__((ext_vector_type(2)));
typedef _Float16 h16x8 __attribute__((ext_vector_type(8)));
__device__ __forceinline__ unsigned f2bf(float f) { return (unsigned)__builtin_bit_cast(unsigned short, (_Float16)f); }
__device__ __forceinline__ unsigned pk2(float lo, float hi) { h16x2 v = {(_Float16)lo, (_Float16)hi}; return __builtin_bit_cast(unsigned, v); }
__device__ __forceinline__ unsigned pkh2(float lo, float hi) { return pk2(lo, hi); }
__device__ __forceinline__ float bflo(unsigned w) { return (float)__builtin_bit_cast(h16x2, w).x; }
__device__ __forceinline__ float bfhi(unsigned w) { return (float)__builtin_bit_cast(h16x2, w).y; }
__device__ __forceinline__ float hlo(unsigned w) { return bflo(w); }
__device__ __forceinline__ float hhi(unsigned w) { return bfhi(w); }
__device__ __forceinline__ float h1f(bf16_t h) { return (float)__builtin_bit_cast(_Float16, h); }
__device__ __forceinline__ float bf1(bf16_t h) { return h1f(h); }
__device__ __forceinline__ bf16x8 pack8(f32x4 a, f32x4 b) { u32x4 w; w.x = pk2(a[0], a[1]); w.y = pk2(a[2], a[3]); w.z = pk2(b[0], b[1]); w.w = pk2(b[2], b[3]); return __builtin_bit_cast(bf16x8, w); }
__device__ __forceinline__ void unpack8(u32x4 w, float* o) { o[0] = bflo(w.x); o[1] = bfhi(w.x); o[2] = bflo(w.y); o[3] = bfhi(w.y); o[4] = bflo(w.z); o[5] = bfhi(w.z); o[6] = bflo(w.w); o[7] = bfhi(w.w); }
__device__ __forceinline__ void unpackh8(u32x4 w, float* o) { unpack8(w, o); }
__device__ __forceinline__ f32x4 mfma16(bf16x8 a, bf16x8 b, f32x4 c) { return __builtin_amdgcn_mfma_f32_16x16x32_f16(__builtin_bit_cast(h16x8, a), __builtin_bit_cast(h16x8, b), c, 0, 0, 0); }
__device__ __forceinline__ unsigned pki2(float lo, float hi) { const int a = (int)rintf(fminf(fmaxf(lo * 4096.f, -32767.f), 32767.f)), b = (int)rintf(fminf(fmaxf(hi * 4096.f, -32767.f), 32767.f)); return ((unsigned)a & 0xffffu) | ((unsigned)b << 16); }
__device__ __forceinline__ void unpacki8(u32x4 w, float* o) { const unsigned ww[4] = {w.x, w.y, w.z, w.w};
#pragma unroll
    for (int e = 0; e < 4; ++e) { o[2 * e] = (float)(short)(ww[e] & 0xffffu); o[2 * e + 1] = (float)(short)(ww[e] >> 16); } }
__device__ __forceinline__ float siluf(float x) { return x * __builtin_amdgcn_rcpf(1.f + __expf(-x)); }
__device__ __forceinline__ int il(int t, int m) { return 8 * (m >> 2) + 4 * t + (m & 3); }

constexpr float LO_SCALE = 2048.f;
__device__ __forceinline__ void split8(const float* v, u32x4& hi, u32x4& lo) {
    float r[8]; unsigned h[8];
#pragma unroll
    for (int e = 0; e < 8; ++e) { const _Float16 hh = (_Float16)v[e]; h[e] = (unsigned)__builtin_bit_cast(unsigned short, hh); r[e] = (v[e] - (float)hh) * LO_SCALE; }
    hi.x = h[0] | (h[1] << 16); hi.y = h[2] | (h[3] << 16); hi.z = h[4] | (h[5] << 16); hi.w = h[6] | (h[7] << 16);
    lo.x = pk2(r[0], r[1]); lo.y = pk2(r[2], r[3]); lo.z = pk2(r[4], r[5]); lo.w = pk2(r[6], r[7]);
}
__device__ __forceinline__ void lds_barrier() { asm volatile("s_waitcnt lgkmcnt(0)" ::: "memory"); __builtin_amdgcn_s_barrier(); asm volatile("" ::: "memory"); }
#define SCHED_FENCE() __builtin_amdgcn_sched_barrier(0)
__device__ __forceinline__ int otid() { int t = threadIdx.x; asm volatile("" : "+v"(t)); return t; }
namespace pg8 {
constexpr int BM = 256, BK = 64, HALF = 128, HTB = HALF * BK * 2, STAGE_BYTES = 8 * HTB, NXCD = 8, WGM = 4;
__device__ __forceinline__ int lds_byte(int r, int c) { const int st = (r >> 4) * 2 + (c >> 5), rr = r & 15, cc = c & 31, ob = rr * 64 + cc * 2; return st * 1024 + (ob ^ (((ob >> 9) & 1) << 5)); }
__device__ __forceinline__ void stage_rc(int b, int& R, int& C) { const int st = b / 1024, sb = b % 1024, swz = sb ^ (((sb >> 9) & 1) << 5); R = (st >> 1) * 16 + swz / 64; C = (st & 1) * 32 + (swz % 64) / 2; }
__device__ __forceinline__ int perm32(int rho) { const int n = rho >> 4, i = rho & 15; return 8 * (i >> 2) + 4 * n + (i & 3); }
struct Unit { int pm, pn; };
struct Gemm { const bf16_t* A; const bf16_t* Bt; int M, N, K; };
struct StaticOrder {
    int nM, nN, nwg, G, c;
    __device__ void init(int M, int N, int G_, int c_) { nM = M / BM; nN = N / BM; nwg = nM * nN; G = G_; c = c_; }
    __device__ bool next(int i, Unit& u) const {
        const long L = (long)i * G + c; if (L >= nwg) return false;
        int wgid = (int)L; { const int q = nwg / NXCD, r = nwg % NXCD, xcd = wgid % NXCD, off = wgid / NXCD; wgid = (xcd < r ? xcd * (q + 1) : r * (q + 1) + (xcd - r) * q) + off; }
        const int nig = WGM * nN, gid = wgid / nig, fm = gid * WGM, gsz = (nM - fm) < WGM ? (nM - fm) : WGM;
        u.pm = fm + ((wgid % nig) % gsz); u.pn = (wgid % nig) / gsz; return true;
    }
};

template <class Epi>
__device__ __forceinline__ void gemm_phase(LAS unsigned char* lds, const Gemm g, const StaticOrder& S, const Epi& E) {
    const int tid = otid(), wid = __builtin_amdgcn_readfirstlane(tid >> 6), lane = tid & 63, wr = wid >> 2, wc = wid & 3, fr = lane & 15, fq = lane >> 4;
    const int K = g.K, nt = K / BK;
    unsigned voffA[2], voffB[2];
#pragma unroll
    for (int i = 0; i < 2; ++i) { int R, C; stage_rc(tid * 16 + i * 8192, R, C); const int Rb = Epi::PERM ? ((R & ~31) + perm32(R & 31)) : R;
        voffA[i] = (unsigned)(R * K + C) * 2u; voffB[i] = (unsigned)(Rb * K + C) * 2u; }
    const size_t kstep = (size_t)(BK * 2);
    const size_t hstep = (size_t)HALF * K * 2;
    const size_t tstep = 2 * hstep;
    const unsigned ldsw = (unsigned)wid * 1024u;
    const int aoff = lds_byte(wr * 64 + fr, fq * 8), boff = lds_byte(wc * 32 + fr, fq * 8);
#define PG8_SA(b, h) (((b) * 2 + (h)) * HTB)
#define PG8_SB(b, h) ((4 + (b) * 2 + (h)) * HTB)
#define PG8_STAGE(bufoff, gbase, voff) do { _Pragma("unroll") for (int _i = 0; _i < 2; ++_i) \
        __builtin_amdgcn_global_load_lds((const unsigned*)((const char*)(gbase) + (voff)[_i]), (LAS unsigned*)(lds + (bufoff) + ldsw + _i * 8192), 16, 0, 0); } while (0)
#define PG8_LDA(dst, b, h) do { _Pragma("unroll") for (int m = 0; m < 4; ++m) _Pragma("unroll") for (int k = 0; k < 2; ++k) dst[m][k] = *(const LAS bf16x8*)(lds + PG8_SA(b, h) + aoff + m * 2048 + k * 1024); } while (0)
#define PG8_LDB(dst, b, h) do { _Pragma("unroll") for (int n = 0; n < 2; ++n) _Pragma("unroll") for (int k = 0; k < 2; ++k) dst[n][k] = *(const LAS bf16x8*)(lds + PG8_SB(b, h) + boff + n * 2048 + k * 1024); } while (0)
#define PG8_MMA(ai, bj, At, Bt) do { __builtin_amdgcn_s_setprio(1); _Pragma("unroll") for (int m = 0; m < 4; ++m) _Pragma("unroll") for (int n = 0; n < 2; ++n) _Pragma("unroll") for (int k = 0; k < 2; ++k) \
        acc[ai][bj][m][n] = __builtin_amdgcn_mfma_f32_16x16x32_f16(__builtin_bit_cast(h16x8, Bt[n][k]), __builtin_bit_cast(h16x8, At[m][k]), acc[ai][bj][m][n], 0, 0, 0); __builtin_amdgcn_s_setprio(0); } while (0)
#define PG8_WAIT_V(n) asm volatile("s_waitcnt vmcnt(" #n ")" ::: "memory")
#define PG8_WAIT_L(n) asm volatile("s_waitcnt lgkmcnt(" #n ")" ::: "memory")
#define PG8_BAR __builtin_amdgcn_s_barrier()
#define PG8_SCHED __builtin_amdgcn_sched_barrier(0)
    Unit cur, nxt; int ui = 0;
    if (!S.next(0, cur)) return;
    f32x4 acc[2][2][4][2];
#pragma unroll
    for (int a = 0; a < 2; ++a)
#pragma unroll
        for (int b = 0; b < 2; ++b)
#pragma unroll
            for (int m = 0; m < 4; ++m)
#pragma unroll
                for (int n = 0; n < 2; ++n) acc[a][b][m][n] = (f32x4){0.f, 0.f, 0.f, 0.f};
    bf16x8 At[4][2], B0[2][2], B1[2][2];
    const char* cA = (const char*)g.A + (size_t)cur.pm * tstep; const char* cB = (const char*)g.Bt + (size_t)cur.pn * tstep;
    PG8_STAGE(PG8_SB(0, 0), cB, voffB); PG8_STAGE(PG8_SA(0, 0), cA, voffA); PG8_STAGE(PG8_SB(0, 1), cB + hstep, voffB); PG8_STAGE(PG8_SA(0, 1), cA + hstep, voffA);
    if (wr == 1) PG8_BAR;
    PG8_WAIT_V(4); PG8_BAR;
    PG8_STAGE(PG8_SB(1, 0), cB + kstep, voffB); PG8_STAGE(PG8_SA(1, 0), cA + kstep, voffA); PG8_STAGE(PG8_SB(1, 1), cB + hstep + kstep, voffB);
    PG8_WAIT_V(6); PG8_BAR;
    for (;;) {
        const bool has_next = S.next(ui + 1, nxt);
        const char* nA = has_next ? (const char*)g.A + (size_t)nxt.pm * tstep : cA; const char* nB = has_next ? (const char*)g.Bt + (size_t)nxt.pn * tstep : cB;
        for (int t = 0; t < nt; t += 2) {
            const bool last = (t == nt - 2);
            const char* a1 = cA + (size_t)(t + 1) * kstep;
            const char* a2 = last ? nA : cA + (size_t)(t + 2) * kstep; const char* b2 = last ? nB : cB + (size_t)(t + 2) * kstep;
            const char* a3 = a2 + kstep; const char* b3 = b2 + kstep;
            PG8_LDB(B0, 0, 0); PG8_SCHED; PG8_LDA(At, 0, 0); PG8_STAGE(PG8_SA(1, 1), a1 + hstep, voffA);
            PG8_WAIT_L(8); PG8_BAR; PG8_WAIT_L(0); PG8_MMA(0, 0, At, B0); PG8_BAR; PG8_SCHED;
            PG8_LDB(B1, 0, 1); PG8_STAGE(PG8_SB(0, 0), b2, voffB);
            PG8_BAR; PG8_WAIT_L(0); PG8_MMA(0, 1, At, B1); PG8_BAR;
            PG8_LDA(At, 0, 1); PG8_STAGE(PG8_SA(0, 0), a2, voffA);
            PG8_BAR; PG8_WAIT_L(0); PG8_MMA(1, 0, At, B0); PG8_BAR; PG8_SCHED;
            PG8_STAGE(PG8_SB(0, 1), b2 + hstep, voffB);
            PG8_WAIT_V(6); PG8_BAR; PG8_MMA(1, 1, At, B1); PG8_BAR;
            PG8_LDB(B0, 1, 0); PG8_SCHED; PG8_LDA(At, 1, 0); PG8_STAGE(PG8_SA(0, 1), a2 + hstep, voffA);
            PG8_WAIT_L(8); PG8_BAR; PG8_WAIT_L(0); PG8_MMA(0, 0, At, B0); PG8_BAR; PG8_SCHED;
            PG8_LDB(B1, 1, 1); PG8_STAGE(PG8_SB(1, 0), b3, voffB);
            PG8_BAR; PG8_WAIT_L(0); PG8_MMA(0, 1, At, B1); PG8_BAR;
            PG8_LDA(At, 1, 1); PG8_STAGE(PG8_SA(1, 0), a3, voffA);
            PG8_BAR; PG8_WAIT_L(0); PG8_MMA(1, 0, At, B0); PG8_BAR; PG8_SCHED;
            PG8_STAGE(PG8_SB(1, 1), b3 + hstep, voffB);
            PG8_WAIT_V(6); PG8_BAR; PG8_MMA(1, 1, At, B1); PG8_BAR;
        }
        if constexpr (!Epi::AFTER_DRAIN) E(acc, cur, wr, wc, fr, fq);
        if (!has_next) break;
#pragma unroll
        for (int a = 0; a < 2; ++a)
#pragma unroll
            for (int b = 0; b < 2; ++b)
#pragma unroll
                for (int m = 0; m < 4; ++m)
#pragma unroll
                    for (int n = 0; n < 2; ++n) acc[a][b][m][n] = (f32x4){0.f, 0.f, 0.f, 0.f};
        cur = nxt; cA = nA; cB = nB; ++ui;
    }
    PG8_WAIT_V(0);
    if (wr == 0) PG8_BAR;
    PG8_BAR;
    if constexpr (Epi::AFTER_DRAIN) E.fused(acc, cur, wr, wc, fr, fq, lds, wid, lane);
#undef PG8_SA
#undef PG8_SB
#undef PG8_STAGE
#undef PG8_LDA
#undef PG8_LDB
#undef PG8_MMA
#undef PG8_WAIT_V
#undef PG8_WAIT_L
#undef PG8_BAR
#undef PG8_SCHED
}
}

struct EpiProj {
    static constexpr bool PERM = true, AFTER_DRAIN = false;
    unsigned char* ws;
    __device__ __forceinline__ void operator()(const f32x4 (&acc)[2][2][4][2], const pg8::Unit& u, int wr, int wc, int fr, int fq) const {
        const int pn = u.pn; const int row0 = u.pm * 256 + wr * 64 + fr;
        if (pn < 14) {
            size_t off; int ldc, colt;
            if (pn < 8) { off = (pn >> 1) == 3 ? WS_DNZ : WS_DNQ + (size_t)(pn >> 1) * 16 * MiB; ldc = 512; colt = (pn & 1) * 256; }
            else if (pn == 8) { off = WS_GQ; ldc = 256; colt = 0; }
            else if (pn == 9) { off = WS_GK; ldc = 256; colt = 0; }
            else if (pn < 12) { off = WS_GV; ldc = 512; colt = (pn - 10) * 256; }
            else { off = WS_GZ; ldc = 512; colt = (pn - 12) * 256; }
            bf16_t* base = (bf16_t*)(ws + off);
            const int col0 = colt + wc * 32 + 8 * fq;
#pragma unroll
            for (int ai = 0; ai < 2; ++ai)
#pragma unroll
                for (int m = 0; m < 4; ++m) { bf16_t* rowp = base + (size_t)(row0 + ai * 128 + m * 16) * ldc + col0;
#pragma unroll
                    for (int bj = 0; bj < 2; ++bj) { const f32x4 v0 = acc[ai][bj][m][0], v1 = acc[ai][bj][m][1];
                        u32x4 w;
                        if (pn < 4) { w.x = pki2(v0[0], v0[1]); w.y = pki2(v0[2], v0[3]); w.z = pki2(v1[0], v1[1]); w.w = pki2(v1[2], v1[3]); }
                        else { w.x = pkh2(v0[0], v0[1]); w.y = pkh2(v0[2], v0[3]); w.z = pkh2(v1[0], v1[1]); w.w = pkh2(v1[2], v1[3]); }
                        *(u32x4*)(rowp + bj * 128) = w; } }
        } else if (wc == 0) {
            float* sm = (float*)(ws + WS_SMALL);
#pragma unroll
            for (int ai = 0; ai < 2; ++ai)
#pragma unroll
                for (int m = 0; m < 4; ++m) { float* rowp = sm + (size_t)(row0 + ai * 128 + m * 16) * 32 + 8 * fq;
                    *(f32x4*)(rowp) = acc[ai][0][m][0]; *(f32x4*)(rowp + 4) = acc[ai][0][m][1]; }
        }
    }
};
struct EpiOutLN {
    static constexpr bool PERM = false, AFTER_DRAIN = true;
    const float* resid; float* out; bf16_t* xb; const float* lng; const float* lnb; unsigned* xbuf; unsigned* cnt;
    __device__ __forceinline__ void operator()(const f32x4 (&)[2][2][4][2], const pg8::Unit&, int, int, int, int) const {}
    __device__ __forceinline__ void fused(f32x4 (&acc)[2][2][4][2], const pg8::Unit& u, int wr, int wc, int fr, int fq, LAS unsigned char* lds, int wid, int lane) const {
        typedef float f32x2v __attribute__((ext_vector_type(2)));
        LAS f32x2v* P = (LAS f32x2v*)lds;
        LAS f32x2v* S = (LAS f32x2v*)(lds + 8192);
        const int col0 = u.pn * 256 + wc * 32 + 4 * fq;
        f32x4 rb[2][4];
#pragma unroll
        for (int i = 0; i < 4; ++i) rb[0][i] = __builtin_nontemporal_load((const f32x4*)(resid + (size_t)(u.pm * 256 + wr * 64 + fr) * DM + col0 + (i >> 1) * 128 + (i & 1) * 16));
#pragma unroll
        for (int g = 0; g < 8; ++g) {
            const int ai = g >> 2, m = g & 3;
            if (g + 1 < 8) { const int ai1 = (g + 1) >> 2, m1 = (g + 1) & 3; const size_t off1 = (size_t)(u.pm * 256 + ai1 * 128 + wr * 64 + m1 * 16 + fr) * DM + col0;
#pragma unroll
                for (int i = 0; i < 4; ++i) rb[(g + 1) & 1][i] = *(const f32x4*)(resid + off1 + (i >> 1) * 128 + (i & 1) * 16); }
#pragma unroll
            for (int i = 0; i < 4; ++i) acc[ai][i >> 1][m][i & 1] = rb[g & 1][i] * DEEP_ALPHA + acc[ai][i >> 1][m][i & 1];
            asm volatile("" : "+v"(acc[ai][0][m][0]), "+v"(acc[ai][0][m][1]), "+v"(acc[ai][1][m][0]), "+v"(acc[ai][1][m][1]));
            SCHED_FENCE();
        }
#pragma unroll
        for (int ai = 0; ai < 2; ++ai)
#pragma unroll
            for (int m = 0; m < 4; ++m) {
                float s = 0.f;
#pragma unroll
                for (int bj = 0; bj < 2; ++bj)
#pragma unroll
                    for (int n = 0; n < 2; ++n) { const f32x4 x = acc[ai][bj][m][n]; s += (x[0] + x[1]) + (x[2] + x[3]); }
                s += __shfl_xor(s, 16); s += __shfl_xor(s, 32);
                const float mw = s * (1.0f / 64.0f); float qq = 0.f;
#pragma unroll
                for (int bj = 0; bj < 2; ++bj)
#pragma unroll
                    for (int n = 0; n < 2; ++n) { const f32x4 d = acc[ai][bj][m][n] - mw; qq += (d[0] * d[0] + d[1] * d[1]) + (d[2] * d[2] + d[3] * d[3]); }
                qq += __shfl_xor(qq, 16); qq += __shfl_xor(qq, 32);
                if (fq == 0) P[(ai * 128 + wr * 64 + m * 16 + fr) * 4 + wc] = (f32x2v){mw, qq};
            }
        asm volatile("s_waitcnt lgkmcnt(0)" ::: "memory"); __builtin_amdgcn_s_barrier(); asm volatile("" ::: "memory");
        const int row = wid * 32 + (lane & 31);
        if (lane < 32) {
            const f32x2v pa = P[row * 4 + 0], pb = P[row * 4 + 1], pc = P[row * 4 + 2], pd = P[row * 4 + 3];
            const float mt = (pa.x + pb.x + pc.x + pd.x) * 0.25f;
            const float da = pa.x - mt, db = pb.x - mt, dc = pc.x - mt, dd = pd.x - mt;
            const float m2 = (pa.y + pb.y) + (pc.y + pd.y) + 64.0f * ((da * da + db * db) + (dc * dc + dd * dd));
            unsigned long long* slot = (unsigned long long*)xbuf + ((size_t)(u.pm * 256 + row) * 4 + u.pn);
            __hip_atomic_store(slot, ((unsigned long long)__float_as_uint(m2) << 32) | __float_as_uint(mt), __ATOMIC_RELAXED, __HIP_MEMORY_SCOPE_AGENT);
        }
        asm volatile("s_waitcnt vmcnt(0)" ::: "memory");
        if (lane == 0) __hip_atomic_fetch_add(cnt + 64 * u.pm, 1u, __ATOMIC_RELAXED, __HIP_MEMORY_SCOPE_AGENT);
        if (wid == 0) {
            unsigned sp = 0;
            while ((unsigned)__builtin_amdgcn_readfirstlane(__hip_atomic_load(cnt + 64 * u.pm, __ATOMIC_RELAXED, __HIP_MEMORY_SCOPE_AGENT)) < 32u) { __builtin_amdgcn_s_sleep(2); if (++sp > (1u << 24)) break; }
            __builtin_amdgcn_fence(__ATOMIC_ACQUIRE, "agent");
        }
        asm volatile("s_waitcnt vmcnt(0) lgkmcnt(0)" ::: "memory"); __builtin_amdgcn_s_barrier(); asm volatile("" ::: "memory");
        if (lane < 32) {
            const unsigned long long* slot = (const unsigned long long*)xbuf + (size_t)(u.pm * 256 + row) * 4; float mt[4], m2[4]; float ms = 0.f;
#pragma unroll
            for (int t = 0; t < 4; ++t) { const unsigned long long wv = __hip_atomic_load(slot + t, __ATOMIC_RELAXED, __HIP_MEMORY_SCOPE_AGENT); mt[t] = __uint_as_float((unsigned)wv); m2[t] = __uint_as_float((unsigned)(wv >> 32)); ms += mt[t]; }
            const float mean = ms * 0.25f; float qq = 0.f;
#pragma unroll
            for (int t = 0; t < 4; ++t) { const float dm = mt[t] - mean; qq += m2[t] + 256.0f * dm * dm; }
            S[row] = (f32x2v){mean, rsqrtf(qq * (1.0f / 1024.0f) + EPS)};
        }
        asm volatile("s_waitcnt lgkmcnt(0)" ::: "memory"); __builtin_amdgcn_s_barrier(); asm volatile("" ::: "memory");
#pragma unroll
        for (int ai = 0; ai < 2; ++ai)
#pragma unroll
            for (int m = 0; m < 4; ++m) { const int r = ai * 128 + wr * 64 + m * 16 + fr; const f32x2v sr = S[r]; const size_t off = (size_t)(u.pm * 256 + r) * DM + col0;
#pragma unroll
                for (int bj = 0; bj < 2; ++bj)
#pragma unroll
                    for (int n = 0; n < 2; ++n) { const f32x4 gg = *(const f32x4*)(lng + col0 + bj * 128 + n * 16), bb = *(const f32x4*)(lnb + col0 + bj * 128 + n * 16);
                        const f32x4 o = (acc[ai][bj][m][n] - sr.x) * sr.y * gg + bb;
                        *(f32x4*)(out + off + bj * 128 + n * 16) = o;
                        if (xb) { u32x2 wv; wv.x = pkh2(o[0], o[1]); wv.y = pkh2(o[2], o[3]); *(u32x2*)(xb + off + bj * 128 + n * 16) = wv; } }
                SCHED_FENCE(); }
    }
};

#define XB_TMO      128
#define XB_XCNT(j)  (256  + 64 * (j))
#define XB_XSUB(j)  (1280 + 64 * (j))
#define XB_XGEN(j)  (2304 + 64 * (j))
#define XB_TOP      3328
#define XB_TOPGEN   3392
#define XCD_BAR_WORDS 3456
#define XB_SPIN_CAP (1u << 22)
__device__ __forceinline__ unsigned xb_ld(unsigned* p)              { return __hip_atomic_load(p, __ATOMIC_RELAXED, __HIP_MEMORY_SCOPE_AGENT); }
__device__ __forceinline__ unsigned xb_add(unsigned* p, unsigned v) { return __hip_atomic_fetch_add(p, v, __ATOMIC_RELAXED, __HIP_MEMORY_SCOPE_AGENT); }
__device__ __forceinline__ unsigned xb_xcc_id() { return (unsigned)__builtin_amdgcn_s_getreg((3 << 11) | 20) & 0xFu; }
#define XB_SPIN(cond, bar) do { unsigned _sp = 0; while (cond) { __builtin_amdgcn_s_sleep(4); \
    if ((++_sp & 255u) == 0u) { if (xb_ld(&(bar)[XB_TMO])) break; if (_sp > XB_SPIN_CAP) { atomicAdd(&(bar)[XB_TMO], 1u); break; } } } } while (0)
struct XcdBarrier { unsigned* bar; unsigned x; volatile LAS unsigned* st; };
__device__ __forceinline__ XcdBarrier xcd_barrier_post(unsigned* bar, volatile LAS unsigned* st) {
    XcdBarrier b; b.bar = bar; b.x = xb_xcc_id(); b.st = st;
    if (threadIdx.x == 0) (void)xb_add(&bar[XB_XCNT(b.x)], 1u);
    return b;
}
__device__ __forceinline__ void xcd_barrier_complete(unsigned* bar, unsigned x, unsigned& nloc, unsigned& nx) {
    const unsigned G = gridDim.x * gridDim.y * gridDim.z;
    unsigned sum, cnt, mine, sp = 0u;
    for (;;) {
        sum = 0u; cnt = 0u; mine = 0u;
#pragma unroll
        for (unsigned j = 0; j < 16; ++j) { const unsigned c = xb_ld(&bar[XB_XCNT(j)]); sum += c; cnt += (c > 0u) ? 1u : 0u; mine = (j == x) ? c : mine; }
        if (sum == G) break;
        __builtin_amdgcn_s_sleep(1);
        if ((++sp & 255u) == 0u) { if (xb_ld(&bar[XB_TMO])) break; if (sp > XB_SPIN_CAP) { atomicAdd(&bar[XB_TMO], 1u); break; } }
    }
    nloc = mine > 0u ? mine : 1u; nx = cnt > 0u ? cnt : 1u;
}
__device__ __forceinline__ void xcd_barrier(const XcdBarrier& b) {
    asm volatile("s_waitcnt vmcnt(0)" ::: "memory");
    __syncthreads();
    if (threadIdx.x == 0) {
        unsigned* bar = b.bar;
        __builtin_amdgcn_s_waitcnt(0);
        unsigned nloc = b.st[0], nx = b.st[1];
        if (nloc == 0u) { xcd_barrier_complete(bar, b.x, nloc, nx); b.st[0] = nloc; b.st[1] = nx; }
        const unsigned old = xb_add(&bar[XB_XSUB(b.x)], 1u);
        const unsigned gen = old / nloc;
        if (old + 1u == (gen + 1u) * nloc) {
            __builtin_amdgcn_fence(__ATOMIC_RELEASE, "agent");
            asm volatile("s_waitcnt vmcnt(0)" ::: "memory");
            const unsigned og = xb_add(&bar[XB_TOP], 1u);
            const unsigned tg = og / nx;
            if (og + 1u == (tg + 1u) * nx) xb_add(&bar[XB_TOPGEN], 1u);
            else XB_SPIN(xb_ld(&bar[XB_TOPGEN]) == tg, bar);
            __builtin_amdgcn_fence(__ATOMIC_ACQUIRE, "agent");
            xb_add(&bar[XB_XGEN(b.x)], 1u);
            asm volatile("s_waitcnt vmcnt(0)" ::: "memory");
        } else {
            XB_SPIN(xb_ld(&bar[XB_XGEN(b.x)]) == gen, bar);
            __builtin_amdgcn_fence(__ATOMIC_ACQUIRE, "agent");
            asm volatile("s_waitcnt vmcnt(0)" ::: "memory");
        }
    }
    __syncthreads();
}
constexpr size_t WS_BAR = 524288;

struct Args {
    const float *x, *w_in, *conv_w, *a_log, *dt_bias, *gw2, *gb, *dn_g, *gla_g, *w_out, *ln_g, *ln_b;
    float* out; unsigned char* ws; int ph_lo, ph_hi;
};

__device__ __forceinline__ int win_src_col(int r) { return r < 2048 ? r : (r < 3584 ? r + 8 : (r < 3592 ? r - 1536 : (r < 3608 ? r : -1))); }
template <bool MAP>
__device__ __forceinline__ void transpose_item(const float* W, int ldw, bf16_t* WT, int nblk, float* scr, int item, int lane) {
    const int kb = item / nblk, nb = item % nblk, k0 = 64 * kb, n0 = 32 * nb;
    const int kk = lane >> 3, n4 = lane & 7;
    const int sc = MAP ? win_src_col(n0 + 4 * n4) : n0 + 4 * n4;
    f32x4 v[8];
#pragma unroll
    for (int i = 0; i < 8; ++i) v[i] = sc >= 0 ? *(const f32x4*)(W + (size_t)(k0 + 8 * i + kk) * ldw + sc) : (f32x4){0.f, 0.f, 0.f, 0.f};
#pragma unroll
    for (int i = 0; i < 8; ++i) { float* s = scr + (8 * i + kk) * 33 + 4 * n4; s[0] = v[i][0]; s[1] = v[i][1]; s[2] = v[i][2]; s[3] = v[i][3]; }
    asm volatile("s_waitcnt lgkmcnt(0)" ::: "memory");
    const int c = lane & 7;
#pragma unroll
    for (int j = 0; j < 4; ++j) { const int n = (lane >> 3) + 8 * j; const float* s = scr + (8 * c) * 33 + n;
        u32x4 o; o.x = pkh2(s[0 * 33], s[1 * 33]); o.y = pkh2(s[2 * 33], s[3 * 33]); o.z = pkh2(s[4 * 33], s[5 * 33]); o.w = pkh2(s[6 * 33], s[7 * 33]);
        *(u32x4*)(WT + (size_t)(n0 + n) * 1024 + k0 + 8 * c) = o; }
    asm volatile("s_waitcnt lgkmcnt(0)" ::: "memory");
}

__device__ __forceinline__ void convert_weights(const Args& a, int l, int gw, int ngw, float* scr, int lane) {
    constexpr int I_IN = 16 * (NPROJ / 32), I_OUT = 16 * 32;
    for (int r = gw; r < I_IN + I_OUT; r += ngw) {
        if (r < I_IN) transpose_item<true>(a.w_in + (size_t)l * DM * 3608, 3608, (bf16_t*)(a.ws + WS_WIN + l * WIN_BYTES), NPROJ / 32, scr, r, lane);
        else transpose_item<false>(a.w_out + (size_t)l * DM * DM, DM, (bf16_t*)(a.ws + WS_WOUT + l * WOUT_BYTES), 32, scr, r - I_IN, lane);
    }
}
__device__ __forceinline__ void prologue(const Args& a, unsigned char* lds) {
    const int tid = otid(), lane = tid & 63, wave = tid >> 6, G = gridDim.x;
    float* scr = (float*)(lds + wave * 8448);
    const int gw = blockIdx.x * 8 + wave, NGW = G * 8;
    convert_weights(a, 0, gw, NGW, scr, lane);
    const size_t n8 = (size_t)MROWS * DM / 8;
    u32x4* xb = (u32x4*)(a.ws + WS_XB);
    for (size_t i = (size_t)blockIdx.x * 512 + tid; i < n8; i += (size_t)G * 512) {
        const f32x4 v0 = __builtin_nontemporal_load((const f32x4*)a.x + 2 * i), v1 = __builtin_nontemporal_load((const f32x4*)a.x + 2 * i + 1);
        u32x4 w; w.x = pkh2(v0[0], v0[1]); w.y = pkh2(v0[2], v0[3]); w.z = pkh2(v1[0], v1[1]); w.w = pkh2(v1[2], v1[3]); xb[i] = w;
    }
}

constexpr int L_KS = 0, L_QS = 17408, L_RT = 34816, L_AF = 71680, L_TB = 89088, L_KD = 98304, L_SG = 116736, L_QL = 117248, L_KL = 134656, L_CW = 152064;
__device__ __forceinline__ void load5(const bf16_t* raw, int tloc, u32x4* rows) {
#pragma unroll
    for (int r = 0; r < 5; ++r) rows[r] = (tloc + r - 3 >= 0) ? *(const u32x4*)(raw + (ptrdiff_t)(r - 3) * 512) : (u32x4){0u, 0u, 0u, 0u};
}
template <bool I16>
__device__ __forceinline__ void conv2(const u32x4* rows, const float* cw, float* o0, float* o1) {
    float xr[5][8];
#pragma unroll
    for (int r = 0; r < 5; ++r) { if (I16) unpacki8(rows[r], xr[r]); else unpackh8(rows[r], xr[r]); }
#pragma unroll
    for (int e = 0; e < 8; ++e) { o0[e] = 0.f; o1[e] = 0.f; }
#pragma unroll
    for (int tap = 0; tap < 4; ++tap) {
        const f32x4 w0 = *(const f32x4*)(cw + tap * 128), w1 = *(const f32x4*)(cw + tap * 128 + 4);
#pragma unroll
        for (int e = 0; e < 4; ++e) { o0[e] += w0[e] * xr[tap][e]; o0[4 + e] += w1[e] * xr[tap][4 + e]; o1[e] += w0[e] * xr[tap + 1][e]; o1[4 + e] += w1[e] * xr[tap + 1][4 + e]; }
    }
#pragma unroll
    for (int e = 0; e < 8; ++e) { o0[e] = siluf(o0[e]); o1[e] = siluf(o1[e]); }
}
__device__ __forceinline__ float sum16(float v) { v += __shfl_xor(v, 1); v += __shfl_xor(v, 2); v += __shfl_xor(v, 4); v += __shfl_xor(v, 8); return v; }

struct DnPre { u32x4 rq[5]; float bl, al; };
__device__ __forceinline__ void dn_preload(const Args& a, int task, int tid, DnPre& p) {
    const int bh = task >> 5, n = task & 31, b = bh >> 2, h = bh & 3; const size_t tok0 = (size_t)b * SEQ + 64 * n;
    const int tp = tid >> 4, c = tid & 15, t0 = 2 * tp; const size_t ro = (tok0 + t0) * 512 + 128 * h + 8 * c;
    load5((const bf16_t*)(a.ws + WS_DNQ) + ro, 64 * n + t0, p.rq);
    if (tid < 64) { const float* sm = (const float*)(a.ws + WS_SMALL) + (tok0 + tid) * 32; p.bl = sm[h]; p.al = sm[4 + h]; }
}
__device__ __forceinline__ void dn_prep(const Args& a, int l, int task, int next, DnPre& P, float dtb, float nexpa, unsigned char* lds) {
    const int tid = otid(), lane = tid & 63, wave = __builtin_amdgcn_readfirstlane(tid >> 6), m = lane & 15, q = lane >> 4;
    const int bh = task >> 5, n = task & 31, b = bh >> 2, h = bh & 3;
    unsigned char* ws = a.ws;
    bf16_t* KS = (bf16_t*)(lds + L_KS); bf16_t* QS = (bf16_t*)(lds + L_QS); bf16_t* RT = (bf16_t*)(lds + L_RT);
    float* AF = (float*)(lds + L_AF); bf16_t* TB = (bf16_t*)(lds + L_TB); bf16_t* KD = (bf16_t*)(lds + L_KD); float* SG = (float*)(lds + L_SG);
    bf16_t* QL = (bf16_t*)(lds + L_QL); bf16_t* KL = (bf16_t*)(lds + L_KL);
    const size_t tok0 = (size_t)b * SEQ + 64 * n;
    u32x4 rq[5], rk[5], rv[5];
#pragma unroll
    for (int r = 0; r < 5; ++r) rq[r] = P.rq[r];
    { const int tp = tid >> 4, c = tid & 15, t0 = 2 * tp; const size_t ro = ((size_t)b * SEQ + 64 * n + t0) * 512 + 128 * h + 8 * c;
      load5((const bf16_t*)(ws + WS_DNK) + ro, 64 * n + t0, rk); load5((const bf16_t*)(ws + WS_DNV) + ro, 64 * n + t0, rv); }
    if (wave == 0) {
        const float bl = P.bl, al = P.al;
        const float beta = __builtin_amdgcn_rcpf(1.f + __expf(-bl));
        const float xs = al + dtb;
        const float ee = __expf(-fabsf(xs));
        const float l1p = ee < 0.03f ? ee * (1.f - ee * (0.5f - ee * 0.33333333f)) : __logf(1.f + ee);
        const float sp = fmaxf(xs, 0.f) + l1p;
        float g = nexpa * sp;
#pragma unroll
        for (int o = 1; o < 64; o <<= 1) { const float t = __shfl_up(g, o); if (lane >= o) g += t; }
        SG[lane] = g; SG[64 + lane] = beta;
    }
    lds_barrier();
    {
        const int tp = tid >> 4, c = tid & 15, t0 = 2 * tp;
        const float G0 = SG[t0], G1 = SG[t0 + 1], be0 = SG[64 + t0], be1 = SG[64 + t0 + 1], Gl = SG[63];
        const int tsw = 2 * (tp ^ (4 * (c & 7)));
        const float* cw = (const float*)(lds + L_CW) + 8 * c;
        float o0[8], o1[8];
        conv2<true>(rq, cw, o0, o1);
        {
            float s0 = 0.f, s1 = 0.f;
#pragma unroll
            for (int e = 0; e < 8; ++e) { s0 += o0[e] * o0[e]; s1 += o1[e] * o1[e]; }
            s0 = sum16(s0); s1 = sum16(s1);
            const float r0 = rsqrtf(s0 + EPS) * 0.08838834764831845f, r1 = rsqrtf(s1 + EPS) * 0.08838834764831845f;
            u32x4 w0, w1, g0, g1; const float e0 = __expf(G0) * 128.f, e1 = __expf(G1) * 128.f;
#pragma unroll
            for (int e = 0; e < 8; ++e) { o0[e] *= r0; o1[e] *= r1; }
            { u32x4 l0, l1; split8(o0, w0, l0); split8(o1, w1, l1); *(u32x4*)(QL + t0 * 136 + 8 * c) = l0; *(u32x4*)(QL + (t0 + 1) * 136 + 8 * c) = l1; }
            *(u32x4*)(QS + t0 * 136 + 8 * c) = w0; *(u32x4*)(QS + (t0 + 1) * 136 + 8 * c) = w1;
            g0.x = pk2(o0[0] * e0, o0[1] * e0); g0.y = pk2(o0[2] * e0, o0[3] * e0); g0.z = pk2(o0[4] * e0, o0[5] * e0); g0.w = pk2(o0[6] * e0, o0[7] * e0);
            g1.x = pk2(o1[0] * e1, o1[1] * e1); g1.y = pk2(o1[2] * e1, o1[3] * e1); g1.z = pk2(o1[4] * e1, o1[5] * e1); g1.w = pk2(o1[6] * e1, o1[7] * e1);
            bf16_t* qt = (bf16_t*)(ws + WS_DQT) + (size_t)task * 8192;
            *(u32x4*)(qt + t0 * 128 + 8 * c) = g0; *(u32x4*)(qt + (t0 + 1) * 128 + 8 * c) = g1;
        }
        conv2<true>(rk, cw + 512, o0, o1);
        {
            float s0 = 0.f, s1 = 0.f;
#pragma unroll
            for (int e = 0; e < 8; ++e) { s0 += o0[e] * o0[e]; s1 += o1[e] * o1[e]; }
            s0 = sum16(s0); s1 = sum16(s1);
            const float r0 = rsqrtf(s0 + EPS), r1 = rsqrtf(s1 + EPS);
#pragma unroll
            for (int e = 0; e < 8; ++e) { o0[e] *= r0; o1[e] *= r1; }
            u32x4 w0, w1;
            { u32x4 l0, l1; split8(o0, w0, l0); split8(o1, w1, l1); *(u32x4*)(KL + t0 * 136 + 8 * c) = l0; *(u32x4*)(KL + (t0 + 1) * 136 + 8 * c) = l1; }
            *(u32x4*)(KS + t0 * 136 + 8 * c) = w0; *(u32x4*)(KS + (t0 + 1) * 136 + 8 * c) = w1;
            const float kb0 = be0 * __expf(G0), kb1 = be1 * __expf(G1), kd0 = __expf(Gl - G0), kd1 = __expf(Gl - G1);
#pragma unroll
            for (int e = 0; e < 8; ++e) {
                *(unsigned*)(RT + (128 + 8 * c + e) * 72 + tsw) = pk2(o0[e] * kb0, o1[e] * kb1);
                *(unsigned*)(KD + (8 * c + e) * 72 + tsw) = pk2(o0[e] * kd0, o1[e] * kd1);
            }
        }
        conv2<false>(rv, cw + 1024, o0, o1);
#pragma unroll
        for (int e = 0; e < 8; ++e) *(unsigned*)(RT + (8 * c + e) * 72 + tsw) = pk2(o0[e] * be0, o1[e] * be1);
    }
    lds_barrier();
    if (next >= 0) dn_preload(a, next, tid, P);
    {
        bf16_t* att = (bf16_t*)(ws + WS_DATT) + (size_t)task * 4096;
        const int na = wave < 2 ? 2 : 1;
        for (int ja = 0; ja < na; ++ja) {
            const int aa = wave + 8 * ja;
            const int Tj = aa < 4 ? 0 : (aa < 7 ? 1 : (aa < 9 ? 2 : 3)), Ti = aa - (Tj == 0 ? 0 : (Tj == 1 ? 3 : (Tj == 2 ? 5 : 6)));
            f32x4 acc = {0.f, 0.f, 0.f, 0.f}, accl = {0.f, 0.f, 0.f, 0.f};
            bf16x8 fav[4], fbv[4], fal[4], fbl[4];
#pragma unroll
            for (int ks = 0; ks < 4; ++ks) {
                fav[ks] = *(const bf16x8*)(KS + (16 * Tj + m) * 136 + 32 * ks + 8 * q); fbv[ks] = *(const bf16x8*)(QS + (16 * Ti + m) * 136 + 32 * ks + 8 * q);
                fal[ks] = *(const bf16x8*)(KL + (16 * Tj + m) * 136 + 32 * ks + 8 * q); fbl[ks] = *(const bf16x8*)(QL + (16 * Ti + m) * 136 + 32 * ks + 8 * q);
            }
            SCHED_FENCE();
#pragma unroll
            for (int ks = 0; ks < 4; ++ks) { accl = mfma16(fal[ks], fbv[ks], accl); acc = mfma16(fav[ks], fbv[ks], acc); accl = mfma16(fav[ks], fbl[ks], accl); }
            acc = acc + accl * (1.f / LO_SCALE);
            const int i = 16 * Ti + m; const float Gi = SG[i]; float v[4];
#pragma unroll
            for (int r = 0; r < 4; ++r) { const int j = 16 * Tj + 4 * q + r; v[r] = (i >= j) ? acc[r] * (128.f * __expf(Gi - SG[j])) : 0.f; }
            u32x2 w; w.x = pk2(v[0], v[1]); w.y = pk2(v[2], v[3]);
            *(u32x2*)(att + i * 64 + 16 * Tj + 4 * q) = w;
        }
        const int nk = wave < 2 ? 0 : (wave < 6 ? 2 : 1), k0 = wave < 6 ? 2 * (wave - 2) : 8 + (wave - 6);
        for (int jk = 0; jk < nk; ++jk) {
            const int kk = k0 + jk;
            const int Ti = kk < 1 ? 0 : (kk < 3 ? 1 : (kk < 6 ? 2 : 3)), Tj = kk - (Ti == 0 ? 0 : (Ti == 1 ? 1 : (Ti == 2 ? 3 : 6)));
            f32x4 acc = {0.f, 0.f, 0.f, 0.f};
            bf16x8 fa[4], fb[4];
#pragma unroll
            for (int ks = 0; ks < 4; ++ks) { fa[ks] = *(const bf16x8*)(KS + (16 * Ti + m) * 136 + 32 * ks + 8 * q); fb[ks] = *(const bf16x8*)(KS + (16 * Tj + m) * 136 + 32 * ks + 8 * q); }
            SCHED_FENCE();
#pragma unroll
            for (int ks = 0; ks < 4; ++ks) acc = mfma16(fa[ks], fb[ks], acc);
            const int j = 16 * Tj + m; const float Gj = SG[j];
#pragma unroll
            for (int r = 0; r < 4; ++r) { const int i = 16 * Ti + 4 * q + r; AF[i * 68 + j] = (i > j) ? SG[64 + i] * acc[r] * __expf(SG[i] - Gj) : 0.f; }
        }
        if (wave >= 6) {
            for (int jz = 0; jz < 3; ++jz) {
                const int z = 3 * (wave - 6) + jz;
                const int Tj = z < 1 ? 1 : (z < 3 ? 2 : 3), Ti = z - (Tj == 1 ? 0 : (Tj == 2 ? 1 : 3));
                *(u32x2*)(att + (16 * Ti + m) * 64 + 16 * Tj + 4 * q) = (u32x2){0u, 0u};
            }
        }
    }
    lds_barrier();
    {
        bf16_t* kdt = (bf16_t*)(ws + WS_KDT) + (size_t)task * 8192;
        for (int idx = tid; idx < 1024; idx += 512) { const int row = idx >> 3, ch = idx & 7; *(u32x4*)(kdt + row * 64 + 8 * ch) = *(const u32x4*)(KD + row * 72 + 8 * (ch ^ ((row >> 3) & 7))); }
        if (tid == 0) ((float*)(ws + WS_EGL))[task] = expf(SG[63]);
        int vz; asm volatile("v_mov_b32 %0, 0" : "=v"(vz));
        const float* AFv = AF + vz;
        float* TL = (float*)(lds + L_QS);
        float* OFF = (float*)(lds + L_KS);
        float* DINV = (float*)(lds + L_KS + 4096);
        if (wave == 0) {
            const int I = lane >> 4, c = lane & 15;
            const float* Ad = AF + (16 * I) * 68 + 16 * I;
            float d[16];
#pragma unroll
            for (int r = 0; r < 16; ++r) {
                float acc = (r == c) ? 1.f : 0.f;
#pragma unroll
                for (int r4 = 0; r4 < (r + 3) / 4; ++r4) {
                    const f32x4 av = *(const f32x4*)(Ad + r * 68 + 4 * r4);
                    if (4 * r4 + 0 < r) acc -= av[0] * d[4 * r4 + 0];
                    if (4 * r4 + 1 < r) acc -= av[1] * d[4 * r4 + 1];
                    if (4 * r4 + 2 < r) acc -= av[2] * d[4 * r4 + 2];
                    if (4 * r4 + 3 < r) acc -= av[3] * d[4 * r4 + 3];
                }
                d[r] = acc;
                DINV[(I * 16 + r) * 16 + c] = acc;
            }
        }
        lds_barrier();
#pragma unroll 1
        for (int I = 0; I < 4; ++I) {
            {
                const int r0 = 16 * I + 2 * wave;
                float s0 = (r0 == lane) ? 1.f : 0.f, s1 = (r0 + 1 == lane) ? 1.f : 0.f;
#pragma unroll 4
                for (int j = 0; j < 16 * I; j += 4) {
                    const float t0 = TL[(j + 0) * 64 + lane], t1 = TL[(j + 1) * 64 + lane], t2 = TL[(j + 2) * 64 + lane], t3 = TL[(j + 3) * 64 + lane];
                    const f32x4 a0 = *(const f32x4*)(AFv + r0 * 68 + j), a1 = *(const f32x4*)(AFv + (r0 + 1) * 68 + j);
                    s0 -= (a0[0] * t0 + a0[1] * t1) + (a0[2] * t2 + a0[3] * t3);
                    s1 -= (a1[0] * t0 + a1[1] * t1) + (a1[2] * t2 + a1[3] * t3);
                }
                OFF[(2 * wave) * 64 + lane] = s0; OFF[(2 * wave + 1) * 64 + lane] = s1;
            }
            lds_barrier();
            {
                const float* Dv = DINV + vz + (I * 16 + 2 * wave) * 16;
                float x[16];
#pragma unroll
                for (int r2 = 0; r2 < 16; ++r2) x[r2] = OFF[r2 * 64 + lane];
                float ta = 0.f, tb = 0.f;
#pragma unroll
                for (int r4 = 0; r4 < 4; ++r4) {
                    const f32x4 da = *(const f32x4*)(Dv + 4 * r4), db = *(const f32x4*)(Dv + 16 + 4 * r4);
                    ta += (da[0] * x[4 * r4] + da[1] * x[4 * r4 + 1]) + (da[2] * x[4 * r4 + 2] + da[3] * x[4 * r4 + 3]);
                    tb += (db[0] * x[4 * r4] + db[1] * x[4 * r4 + 1]) + (db[2] * x[4 * r4 + 2] + db[3] * x[4 * r4 + 3]);
                }
                const int ra = 16 * I + 2 * wave;
                TL[ra * 64 + lane] = ta; TL[(ra + 1) * 64 + lane] = tb;
                TB[ra * 72 + lane] = (bf16_t)f2bf(ta); TB[(ra + 1) * 72 + lane] = (bf16_t)f2bf(tb);
            }
            lds_barrier();
        }
    }
    {
        bf16_t* ut = (bf16_t*)(ws + WS_UT) + (size_t)task * 8192;
        {
            const int swb = (2 * wave + (m >> 3)) & 7;
            bf16x8 bv[2], fa[8];
#pragma unroll
            for (int s = 0; s < 2; ++s) bv[s] = *(const bf16x8*)(RT + (16 * wave + m) * 72 + 8 * ((4 * s + q) ^ swb));
#pragma unroll
            for (int i = 0; i < 8; ++i) { const int P = i >> 2, s = (i >> 1) & 1, t = i & 1; fa[i] = *(const bf16x8*)(TB + (32 * P + il(t, m)) * 72 + 32 * s + 8 * q); }
            SCHED_FENCE();
#pragma unroll
            for (int P = 0; P < 2; ++P) {
                f32x4 c0 = {0.f, 0.f, 0.f, 0.f}, c1 = {0.f, 0.f, 0.f, 0.f};
#pragma unroll
                for (int s = 0; s < 2; ++s) { c0 = mfma16(fa[4 * P + 2 * s], bv[s], c0); c1 = mfma16(fa[4 * P + 2 * s + 1], bv[s], c1); }
                *(bf16x8*)(ut + (16 * wave + m) * 64 + 32 * P + 8 * q) = pack8(c0, c1);
            }
        }
        bf16_t* nw = (bf16_t*)(ws + WS_NEGW) + (size_t)task * 8192;
        {
            const int Pd = wave >> 1, swa = (4 * Pd + (m >> 2)) & 7;
            bf16x8 fb[4], fa[4];
#pragma unroll
            for (int i = 0; i < 4; ++i) { const int tt = i >> 1, s = i & 1; fb[i] = *(const bf16x8*)(TB + (16 * (2 * (wave & 1) + tt) + m) * 72 + 32 * s + 8 * q); }
#pragma unroll
            for (int i = 0; i < 4; ++i) { const int s = i >> 1, t = i & 1; fa[i] = *(const bf16x8*)(RT + (128 + 32 * Pd + il(t, m)) * 72 + 8 * ((4 * s + q) ^ swa)); }
            SCHED_FENCE();
#pragma unroll
            for (int tt = 0; tt < 2; ++tt) {
                const int Ti = 2 * (wave & 1) + tt;
                f32x4 c0 = {0.f, 0.f, 0.f, 0.f}, c1 = {0.f, 0.f, 0.f, 0.f};
#pragma unroll
                for (int s = 0; s < 2; ++s) { c0 = mfma16(fa[2 * s], fb[2 * tt + s], c0); c1 = mfma16(fa[2 * s + 1], fb[2 * tt + s], c1); }
                *(bf16x8*)(nw + (16 * Ti + m) * 128 + 32 * Pd + 8 * q) = pack8(-c0, -c1);
            }
        }
    }
    lds_barrier();
}

constexpr int G_QS = 0, G_KS = 9216, G_KDT = 18432, G_VT = 27648, G_TOT = 46080, G_GR = 48128, G_W2 = 52224;
__device__ __forceinline__ void gla_prep(const Args& a, int l, int task, unsigned char* lds) {
    const int tid = otid(), lane = tid & 63, wave = __builtin_amdgcn_readfirstlane(tid >> 6), m = lane & 15, q = lane >> 4;
    const int bh = task >> 5, n = task & 31, b = bh >> 2, h = bh & 3;
    unsigned char* ws = a.ws;
    bf16_t* QS = (bf16_t*)(lds + G_QS); bf16_t* KS = (bf16_t*)(lds + G_KS); bf16_t* KDT = (bf16_t*)(lds + G_KDT); bf16_t* VT = (bf16_t*)(lds + G_VT);
    float* TOT = (float*)(lds + G_TOT);
    const size_t tok0 = (size_t)b * SEQ + 64 * n;
    const int d = lane, tg = wave;
    float* GR = (float*)(lds + G_GR);
    f32x4 grv;
    if (tid < 256) grv = *(const f32x4*)((const float*)(ws + WS_SMALL) + (tok0 + (tid >> 2)) * 32 + 8 + 4 * (tid & 3));
    float c[8];
    bf16_t qraw[8], kraw[8];
    {
        const bf16_t* qp = (const bf16_t*)(ws + WS_GQ) + (tok0 + 8 * tg) * 256 + 64 * h + d;
        const bf16_t* kp = (const bf16_t*)(ws + WS_GK) + (tok0 + 8 * tg) * 256 + 64 * h + d;
#pragma unroll
        for (int tt = 0; tt < 8; ++tt) { qraw[tt] = qp[tt * 256]; kraw[tt] = kp[tt * 256]; }
    }
    const int vt = tid >> 3, vc2 = tid & 7;
    const bf16_t* vp = (const bf16_t*)(ws + WS_GV) + (tok0 + vt) * 512 + 128 * h + 16 * vc2;
    const u32x4 vw0 = *(const u32x4*)vp, vw1 = *(const u32x4*)(vp + 8);
    if (tid < 256) *(f32x4*)(GR + (tid >> 2) * 16 + 4 * (tid & 3)) = grv;
    lds_barrier();
    {
        float w2[16];
        const float* W2L = (const float*)(lds + G_W2);
#pragma unroll
        for (int r = 0; r < 16; ++r) w2[r] = W2L[r * 64 + d];
        const float bias = W2L[1024 + d];
        float run = 0.f;
#pragma unroll
        for (int tt = 0; tt < 8; ++tt) {
            const float* gr = GR + (8 * tg + tt) * 16;
            float lg = bias;
#pragma unroll
            for (int r4 = 0; r4 < 4; ++r4) { const f32x4 gv = *(const f32x4*)(gr + 4 * r4); lg += gv[0] * w2[4 * r4] + gv[1] * w2[4 * r4 + 1] + gv[2] * w2[4 * r4 + 2] + gv[3] * w2[4 * r4 + 3]; }
            const float lf = (fminf(lg, 0.f) - __logf(1.f + __expf(-fabsf(lg)))) * 0.0625f;
            run += lf; c[tt] = run;
        }
        TOT[tg * 64 + d] = run;
    }
    {
        const int t = vt, c2 = vc2;
        const unsigned ww[8] = {vw0.x, vw0.y, vw0.z, vw0.w, vw1.x, vw1.y, vw1.z, vw1.w};
#pragma unroll
        for (int e = 0; e < 8; ++e) { VT[(16 * c2 + 2 * e) * 72 + t] = (bf16_t)(ww[e] & 0xffffu); VT[(16 * c2 + 2 * e + 1) * 72 + t] = (bf16_t)(ww[e] >> 16); }
    }
    lds_barrier();
    {
        float pre = 0.f, Bl = 0.f;
#pragma unroll
        for (int g = 0; g < 8; ++g) { const float tv = TOT[g * 64 + d]; if (g < tg) pre += tv; Bl += tv; }
        bf16_t* qt = (bf16_t*)(ws + WS_GQT) + (size_t)task * 4096;
        float kd[8];
#pragma unroll
        for (int tt = 0; tt < 8; ++tt) {
            const float Bv = c[tt] + pre; const int t = 8 * tg + tt;
            const float Rh = 0.5f * Bl;
            const float qv = h1f(qraw[tt]) * 0.125f * __expf(fminf(fmaxf(Bv - Rh, -9.5f), 9.5f)), kv = h1f(kraw[tt]);
            const bf16_t qb = (bf16_t)f2bf(qv);
            QS[t * 72 + d] = qb; qt[t * 64 + d] = qb;
            KS[t * 72 + d] = (bf16_t)f2bf(kv * __expf(fmaxf(fminf(Rh - Bv, 9.5f), -9.5f)));
            kd[tt] = kv * __expf(Bl - Bv);
        }
        u32x4 w; w.x = pk2(kd[0], kd[1]); w.y = pk2(kd[2], kd[3]); w.z = pk2(kd[4], kd[5]); w.w = pk2(kd[6], kd[7]);
        *(u32x4*)(KDT + d * 72 + 8 * tg) = w;
        if (tg == 0) ((float*)(ws + WS_EBL))[(size_t)task * 64 + d] = expf(Bl);
    }
    lds_barrier();
    {
        bf16_t* vt = (bf16_t*)(ws + WS_GVT) + (size_t)task * 8192;
        for (int idx = tid; idx < 1024; idx += 512) { const int row = idx >> 3, ch = idx & 7; *(u32x4*)(vt + row * 64 + 8 * ch) = *(const u32x4*)(VT + row * 72 + 8 * ch); }
    }
    {
        bf16_t* att = (bf16_t*)(ws + WS_GATT) + (size_t)task * 4096;
#pragma unroll
        for (int tt = 0; tt < 2; ++tt) {
            const int tile = 2 * wave + tt, Tj = tile >> 2, Ti = tile & 3;
            f32x4 acc = {0.f, 0.f, 0.f, 0.f};
            if (Ti >= Tj) {
#pragma unroll
                for (int ks = 0; ks < 2; ++ks) {
                    const bf16x8 av = *(const bf16x8*)(KS + (16 * Tj + m) * 72 + 32 * ks + 8 * q), bv = *(const bf16x8*)(QS + (16 * Ti + m) * 72 + 32 * ks + 8 * q);
                    acc = mfma16(av, bv, acc);
                }
            }
            const int i = 16 * Ti + m; float v[4];
#pragma unroll
            for (int r = 0; r < 4; ++r) { const int j = 16 * Tj + 4 * q + r; v[r] = (i >= j) ? acc[r] : 0.f; }
            u32x2 w; w.x = pk2(v[0], v[1]); w.y = pk2(v[2], v[3]);
            *(u32x2*)(att + i * 64 + 16 * Tj + 4 * q) = w;
        }
    }
    {
        bf16_t* st = (bf16_t*)(ws + WS_GST) + (size_t)task * 8192;
#pragma unroll
        for (int Tk = 0; Tk < 4; ++Tk) {
            f32x4 acc = {0.f, 0.f, 0.f, 0.f};
#pragma unroll
            for (int s = 0; s < 2; ++s) {
                const bf16x8 av = *(const bf16x8*)(KDT + (16 * Tk + m) * 72 + 32 * s + 8 * q), bv = *(const bf16x8*)(VT + (16 * wave + m) * 72 + 32 * s + 8 * q);
                acc = mfma16(av, bv, acc);
            }
            u32x2 w; w.x = pk2(acc[0], acc[1]); w.y = pk2(acc[2], acc[3]);
            *(u32x2*)(st + (16 * wave + m) * 64 + 16 * Tk + 4 * q) = w;
        }
    }
    lds_barrier();
}

constexpr int SC_NW = 0, SC_KD = 17408, SC_BUF = 35840;
struct ScanSet { u32x4 pw[2], pk[2], pu[2]; };
__device__ __forceinline__ void scan_load(unsigned char* ws, size_t task, int tid, int w, int m, int q, ScanSet& s) {
    const bf16_t* negW = (const bf16_t*)(ws + WS_NEGW) + task * 8192; const bf16_t* kdT = (const bf16_t*)(ws + WS_KDT) + task * 8192; const bf16_t* uT = (const bf16_t*)(ws + WS_UT) + task * 8192;
#pragma unroll
    for (int i = 0; i < 2; ++i) { const int idx = tid + 512 * i; s.pw[i] = *(const u32x4*)(negW + idx * 8); s.pk[i] = *(const u32x4*)(kdT + idx * 8); s.pu[i] = *(const u32x4*)(uT + (16 * w + m) * 64 + 32 * i + 8 * q); }
}
__device__ __forceinline__ void scan_stage(unsigned char* buf, int tid, const ScanSet& s) {
#pragma unroll
    for (int i = 0; i < 2; ++i) { const int idx = tid + 512 * i;
        *(u32x4*)(buf + SC_NW + ((idx >> 4) * 136 + (((idx & 15) ^ (((idx >> 8) & 1) << 2)) * 8)) * 2) = s.pw[i];
        *(u32x4*)(buf + SC_KD + ((idx >> 3) * 72 + (((idx & 7) ^ (((idx >> 7) & 1) << 2)) * 8)) * 2) = s.pk[i]; }
}
__device__ __forceinline__ void dn_scan(const Args& a, int bh, int half, unsigned char* lds) {
    const int tid = otid(), lane = tid & 63, wv = __builtin_amdgcn_readfirstlane(tid >> 6), w = 4 * half + (wv & 3), m = lane & 15, q = lane >> 4;
    const bool active = wv < 4;
    unsigned char* ws = a.ws;
    f32x4 S[8];
#pragma unroll
    for (int i = 0; i < 8; ++i) S[i] = (f32x4){0.f, 0.f, 0.f, 0.f};
    const float eglv = ((const float*)(ws + WS_EGL))[(size_t)bh * 32 + (lane & 31)];
    ScanSet A, B; u32x4 cu0, cu1;
    { ScanSet t0; scan_load(ws, (size_t)bh * 32, tid, w, m, q, t0); scan_load(ws, (size_t)bh * 32 + 1, tid, w, m, q, B); scan_stage(lds, tid, t0); cu0 = t0.pu[0]; cu1 = t0.pu[1]; }
    __syncthreads();
#define SCAN_STEP(n, ISSUE, STAGE) do { \
        const size_t task = (size_t)bh * 32 + (n); \
        unsigned char* buf = lds + ((n) & 1) * SC_BUF; \
        const bf16_t* NW = (const bf16_t*)(buf + SC_NW); const bf16_t* KD = (const bf16_t*)(buf + SC_KD); \
        bf16_t* uT = (bf16_t*)(ws + WS_UT) + task * 8192; bf16_t* ST = (bf16_t*)(ws + WS_DNST) + task * 16384; \
        const float egl = __shfl(eglv, (n)); \
        if ((n) + 2 < 32) scan_load(ws, task + 2, tid, w, m, q, ISSUE); \
        if (active) { \
        bf16x8 Sb[4], Vb[2]; \
        _Pragma("unroll") for (int ks = 0; ks < 4; ++ks) { Sb[ks] = pack8(S[2 * ks], S[2 * ks + 1]); *(bf16x8*)(ST + (16 * w + m) * 128 + 32 * ks + 8 * q) = Sb[ks]; } \
        bf16x8 fa[8], fb[8]; \
        _Pragma("unroll") for (int i = 0; i < 8; ++i) { const int ks = i >> 1, t = i & 1; fa[i] = *(const bf16x8*)(NW + il(t, m) * 136 + ((4 * ks + q) ^ ((m >> 3) << 2)) * 8); } \
        SCHED_FENCE(); \
        f32x4 v0 = {bflo(cu0.x), bfhi(cu0.x), bflo(cu0.y), bfhi(cu0.y)}, v1 = {bflo(cu0.z), bfhi(cu0.z), bflo(cu0.w), bfhi(cu0.w)}; \
        _Pragma("unroll") for (int ks = 0; ks < 4; ++ks) { v0 = mfma16(fa[2 * ks], Sb[ks], v0); v1 = mfma16(fa[2 * ks + 1], Sb[ks], v1); } \
        _Pragma("unroll") for (int i = 0; i < 8; ++i) { const int ks = i >> 1, t = i & 1; fb[i] = *(const bf16x8*)(NW + (32 + il(t, m)) * 136 + ((4 * ks + q) ^ ((m >> 3) << 2)) * 8); } \
        SCHED_FENCE(); \
        Vb[0] = pack8(v0, v1); \
        *(bf16x8*)(uT + (16 * w + m) * 64 + 8 * q) = Vb[0]; \
        v0 = (f32x4){bflo(cu1.x), bfhi(cu1.x), bflo(cu1.y), bfhi(cu1.y)}; v1 = (f32x4){bflo(cu1.z), bfhi(cu1.z), bflo(cu1.w), bfhi(cu1.w)}; \
        _Pragma("unroll") for (int ks = 0; ks < 4; ++ks) { v0 = mfma16(fb[2 * ks], Sb[ks], v0); v1 = mfma16(fb[2 * ks + 1], Sb[ks], v1); } \
        _Pragma("unroll") for (int i = 0; i < 8; ++i) { const int Pd = i >> 2, t = (i >> 1) & 1, s = i & 1; fa[i] = *(const bf16x8*)(KD + (32 * Pd + il(t, m)) * 72 + ((4 * s + q) ^ ((m >> 3) << 2)) * 8); } \
        SCHED_FENCE(); \
        Vb[1] = pack8(v0, v1); \
        *(bf16x8*)(uT + (16 * w + m) * 64 + 32 + 8 * q) = Vb[1]; \
        _Pragma("unroll") for (int i = 0; i < 8; i += 2) { const int Pd = i >> 2, t = (i >> 1) & 1; \
            f32x4 acc = S[2 * Pd + t] * egl; acc = mfma16(fa[i], Vb[0], acc); acc = mfma16(fa[i + 1], Vb[1], acc); S[2 * Pd + t] = acc; } \
        _Pragma("unroll") for (int i = 0; i < 8; ++i) { const int Pd = 2 + (i >> 2), t = (i >> 1) & 1, s = i & 1; fb[i] = *(const bf16x8*)(KD + (32 * Pd + il(t, m)) * 72 + ((4 * s + q) ^ ((m >> 3) << 2)) * 8); } \
        SCHED_FENCE(); \
        _Pragma("unroll") for (int i = 0; i < 8; i += 2) { const int Pd = 2 + (i >> 2), t = (i >> 1) & 1; \
            f32x4 acc = S[2 * Pd + t] * egl; acc = mfma16(fb[i], Vb[0], acc); acc = mfma16(fb[i + 1], Vb[1], acc); S[2 * Pd + t] = acc; } \
        SCHED_FENCE(); } \
        if ((n) + 1 < 32) { scan_stage(lds + (((n) + 1) & 1) * SC_BUF, tid, STAGE); cu0 = STAGE.pu[0]; cu1 = STAGE.pu[1]; } \
        lds_barrier(); } while (0)
#pragma unroll 1
    for (int n = 0; n < 32; n += 2) { SCAN_STEP(n, A, B); SCAN_STEP(n + 1, B, A); }
#undef SCAN_STEP
}
__device__ __forceinline__ void gla_prefix(const Args& a, int vb, int nvb) {
    unsigned char* ws = a.ws;
    for (int item = vb * 512 + otid(); item < 32768; item += nvb * 512) {
        const int bh = item >> 10, dv = (item >> 3) & 127, kg = item & 7;
        float S[8];
#pragma unroll
        for (int e = 0; e < 8; ++e) S[e] = 0.f;
        for (int n0 = 0; n0 < 32; n0 += 8) {
            u32x4 dw[8]; f32x4 e0[8], e1[8];
#pragma unroll
            for (int j = 0; j < 8; ++j) {
                const size_t task = (size_t)bh * 32 + n0 + j;
                dw[j] = *(const u32x4*)((const bf16_t*)(ws + WS_GST) + task * 8192 + dv * 64 + 8 * kg);
                const float* eb = (const float*)(ws + WS_EBL) + task * 64 + 8 * kg;
                e0[j] = *(const f32x4*)eb; e1[j] = *(const f32x4*)(eb + 4);
            }
#pragma unroll
            for (int j = 0; j < 8; ++j) {
                const size_t task = (size_t)bh * 32 + n0 + j;
                const f32x4 r0 = {sqrtf(e0[j][0]), sqrtf(e0[j][1]), sqrtf(e0[j][2]), sqrtf(e0[j][3])}, r1 = {sqrtf(e1[j][0]), sqrtf(e1[j][1]), sqrtf(e1[j][2]), sqrtf(e1[j][3])};
                u32x4 o; o.x = pk2(S[0] * r0[0], S[1] * r0[1]); o.y = pk2(S[2] * r0[2], S[3] * r0[3]); o.z = pk2(S[4] * r1[0], S[5] * r1[1]); o.w = pk2(S[6] * r1[2], S[7] * r1[3]);
                *(u32x4*)((bf16_t*)(ws + WS_GST) + task * 8192 + dv * 64 + 8 * kg) = o;
                float dS[8]; unpack8(dw[j], dS);
                S[0] = S[0] * e0[j][0] + dS[0]; S[1] = S[1] * e0[j][1] + dS[1]; S[2] = S[2] * e0[j][2] + dS[2]; S[3] = S[3] * e0[j][3] + dS[3];
                S[4] = S[4] * e1[j][0] + dS[4]; S[5] = S[5] * e1[j][1] + dS[5]; S[6] = S[6] * e1[j][2] + dS[6]; S[7] = S[7] * e1[j][3] + dS[7];
            }
        }
    }
}

template <int DK>
__device__ __forceinline__ void out_phase(const Args& a, int l, bool gla, int first, int stride, unsigned char* lds) {
    const int tid = otid(), lane = tid & 63, w = __builtin_amdgcn_readfirstlane(tid >> 6), m = lane & 15, q = lane >> 4;
    unsigned char* ws = a.ws;
    constexpr int QP = DK + 8, NQ = 64 * DK / 8 / 512;
    constexpr int B_AT = 64 * QP * 2, B_SZ = B_AT + 64 * 72 * 2, O_RED = 2 * B_SZ;
    const float oscale = gla ? 1.f : (1.f / 128.f);
    const bf16_t* STb = (const bf16_t*)(ws + (gla ? WS_GST : WS_DNST)); const bf16_t* QTb = (const bf16_t*)(ws + (gla ? WS_GQT : WS_DQT));
    const bf16_t* VTb = (const bf16_t*)(ws + (gla ? WS_GVT : WS_UT)); const bf16_t* ATb = (const bf16_t*)(ws + (gla ? WS_GATT : WS_DATT));
    const bf16_t* Z = (const bf16_t*)(ws + (gla ? WS_GZ : WS_DNZ));
    bf16_t* O = (bf16_t*)(ws + WS_O);
    const f32x4 gv = *(const f32x4*)((gla ? a.gla_g : a.dn_g) + l * 128 + 16 * w + 4 * q);
    u32x4 pq[NQ], pa, pS[DK / 32], pV[2]; u32x2 pz[4];
    if (first >= NTASK) return;
#define OUT_LOAD(task) do { const size_t _t = (size_t)(task); const int _bh = (task) >> 5, _n = (task) & 31; const size_t _tok0 = (size_t)(_bh >> 2) * SEQ + 64 * _n; \
        _Pragma("unroll") for (int i = 0; i < NQ; ++i) pq[i] = *(const u32x4*)(QTb + _t * (64 * DK) + (tid + 512 * i) * 8); \
        pa = *(const u32x4*)(ATb + _t * 4096 + tid * 8); \
        _Pragma("unroll") for (int ks = 0; ks < DK / 32; ++ks) pS[ks] = *(const u32x4*)(STb + _t * (128 * DK) + (16 * w + m) * DK + 32 * ks + 8 * q); \
        _Pragma("unroll") for (int s = 0; s < 2; ++s) pV[s] = *(const u32x4*)(VTb + _t * 8192 + (16 * w + m) * 64 + 32 * s + 8 * q); \
        _Pragma("unroll") for (int Ti = 0; Ti < 4; ++Ti) pz[Ti] = *(const u32x2*)(Z + (_tok0 + 16 * Ti + m) * 512 + 128 * (_bh & 3) + 16 * w + 4 * q); } while (0)
#define OUT_STAGE(buf) do { unsigned char* _b = lds + (buf) * B_SZ; \
        _Pragma("unroll") for (int i = 0; i < NQ; ++i) { const int idx = tid + 512 * i; *(u32x4*)(_b + ((idx / (DK / 8)) * QP + (idx % (DK / 8)) * 8) * 2) = pq[i]; } \
        *(u32x4*)(_b + B_AT + ((tid >> 3) * 72 + (tid & 7) * 8) * 2) = pa; } while (0)
    OUT_LOAD(first);
    OUT_STAGE(0);
    __syncthreads();
    int it = 0;
    for (int task = first; task < NTASK; task += stride, ++it) {
        const int bh = task >> 5, n = task & 31, h = bh & 3;
        const size_t tok0 = (size_t)(bh >> 2) * SEQ + 64 * n;
        u32x4 cS[DK / 32], cV[2]; u32x2 cz[4];
#pragma unroll
        for (int ks = 0; ks < DK / 32; ++ks) cS[ks] = pS[ks];
        cV[0] = pV[0]; cV[1] = pV[1];
#pragma unroll
        for (int Ti = 0; Ti < 4; ++Ti) cz[Ti] = pz[Ti];
        const bool more = task + stride < NTASK;
        if (more) OUT_LOAD(task + stride);
        const bf16_t* QS = (const bf16_t*)(lds + (it & 1) * B_SZ); const bf16_t* AS = (const bf16_t*)(lds + (it & 1) * B_SZ + B_AT);
        float* red = (float*)(lds + O_RED) + (it & 1) * 512;
        f32x4 acc[4];
#pragma unroll
        for (int Ti = 0; Ti < 4; ++Ti) acc[Ti] = (f32x4){0.f, 0.f, 0.f, 0.f};
#pragma unroll
        for (int ks = 0; ks < DK / 32; ks += 2) {
            bf16x8 fb[8];
#pragma unroll
            for (int i = 0; i < 8; ++i) fb[i] = *(const bf16x8*)(QS + (16 * (i & 3) + m) * QP + 32 * (ks + (i >> 2)) + 8 * q);
            SCHED_FENCE();
#pragma unroll
            for (int i = 0; i < 8; ++i) acc[i & 3] = mfma16(__builtin_bit_cast(bf16x8, cS[ks + (i >> 2)]), fb[i], acc[i & 3]);
            SCHED_FENCE();
        }
        {
            bf16x8 fb[8];
#pragma unroll
            for (int i = 0; i < 8; ++i) fb[i] = *(const bf16x8*)(AS + (16 * (i & 3) + m) * 72 + 32 * (i >> 2) + 8 * q);
            SCHED_FENCE();
#pragma unroll
            for (int i = 0; i < 8; ++i) acc[i & 3] = mfma16(__builtin_bit_cast(bf16x8, cV[i >> 2]), fb[i], acc[i & 3]);
            SCHED_FENCE();
        }
#pragma unroll
        for (int Ti = 0; Ti < 4; ++Ti) {
            acc[Ti] = acc[Ti] * oscale;
            float ss = acc[Ti][0] * acc[Ti][0] + acc[Ti][1] * acc[Ti][1] + acc[Ti][2] * acc[Ti][2] + acc[Ti][3] * acc[Ti][3];
            ss += __shfl_xor(ss, 16); ss += __shfl_xor(ss, 32);
            if (q == 0) red[w * 64 + 16 * Ti + m] = ss;
        }
        if (more) OUT_STAGE((it + 1) & 1);
        lds_barrier();
#pragma unroll
        for (int Ti = 0; Ti < 4; ++Ti) {
            const int t = 16 * Ti + m;
            float tot = 0.f;
#pragma unroll
            for (int ww = 0; ww < 8; ++ww) tot += red[ww * 64 + t];
            const float rstd = rsqrtf(tot * (1.f / 128.f) + EPS);
            const float z0 = hlo(cz[Ti].x), z1 = hhi(cz[Ti].x), z2 = hlo(cz[Ti].y), z3 = hhi(cz[Ti].y);
            u32x2 o; o.x = pkh2(acc[Ti][0] * rstd * gv[0] * siluf(z0), acc[Ti][1] * rstd * gv[1] * siluf(z1));
            o.y = pkh2(acc[Ti][2] * rstd * gv[2] * siluf(z2), acc[Ti][3] * rstd * gv[3] * siluf(z3));
            *(u32x2*)(O + (tok0 + t) * 1024 + (gla ? 512 : 0) + 128 * h + 16 * w + 4 * q) = o;
        }
    }
    __syncthreads();
#undef OUT_LOAD
#undef OUT_STAGE
}

constexpr int LDS_BYTES = 152064 + 6144 + 16;
__global__ void __launch_bounds__(512, 2) mk_fwd(Args a) {
    extern __shared__ __attribute__((aligned(16))) unsigned char lds[];
    cg::grid_group grid = cg::this_grid();
    const int G = gridDim.x, bid = blockIdx.x;
    int ph = 0;
#define PHASE_BEGIN if (ph >= a.ph_lo && ph < a.ph_hi) {
#define PHASE_END   if (ph + 1 < a.ph_hi) { \
        xcd_barrier(xbar); } \
    } ++ph;
    volatile LAS unsigned* bst = (volatile LAS unsigned*)((LAS unsigned char*)lds + LDS_BYTES - 16);
    if (threadIdx.x < 4) bst[threadIdx.x] = 0u;
    __syncthreads();
    const XcdBarrier xbar = xcd_barrier_post((unsigned*)(a.ws + WS_BAR), bst);
    if (a.ph_hi > 4096) grid.sync();
    PHASE_BEGIN prologue(a, lds); PHASE_END
    for (int l = 0; l < 2; ++l) {
        const float* resid = l == 0 ? a.x : a.out;
        PHASE_BEGIN {
            pg8::Gemm g{(const bf16_t*)(a.ws + WS_XB), (const bf16_t*)(a.ws + WS_WIN + l * WIN_BYTES), MROWS, NPROJ, DM};
            pg8::StaticOrder S; S.init(MROWS, NPROJ, G, bid); EpiProj E{a.ws};
            pg8::gemm_phase<EpiProj>((LAS unsigned char*)lds, g, S, E);
        } PHASE_END
        PHASE_BEGIN
            { DnPre P; if (bid < NTASK) dn_preload(a, bid, otid(), P);
              int hs = -1; float dtb = 0.f, nexpa = 0.f;
              for (int t = bid; t < NTASK; t += G) {
                  const int h = (t >> 5) & 3;
                  if (h != hs) {
                      const int tt = otid();
                      if (tt < 384) { const int X = tt >> 7, r = tt & 127, tap = r >> 5, c4 = r & 31;
                          const float sc = X < 2 ? (1.f / 4096.f) : 1.f;
                          *(f32x4*)((float*)(lds + L_CW) + X * 512 + tap * 128 + 4 * c4) = *(const f32x4*)(a.conv_w + (size_t)l * 4 * 1536 + tap * 1536 + X * 512 + 128 * h + 4 * c4) * sc; }
                      dtb = a.dt_bias[l * 4 + h]; nexpa = -__expf(a.a_log[l * 4 + h]);
                      hs = h; lds_barrier();
                  }
                  dn_prep(a, l, t, t + G < NTASK ? t + G : -1, P, dtb, nexpa, lds);
              } }
            { int hs = -1;
              for (int t = bid; t < NTASK; t += G) {
                  const int h = (t >> 5) & 3;
                  if (h != hs) {
                      const int tt = otid(); float* W2L = (float*)(lds + G_W2);
                      for (int i = tt; i < 1088; i += 512) W2L[i] = i < 1024 ? a.gw2[(size_t)l * 16 * 256 + (i >> 6) * 256 + 64 * h + (i & 63)] : a.gb[l * 256 + 64 * h + (i - 1024)];
                      hs = h; lds_barrier();
                  }
                  gla_prep(a, l, t, lds);
              } }
        PHASE_END
        PHASE_BEGIN
            if (bid < 64) dn_scan(a, (bid & 7) + 8 * (bid >> 4), (bid >> 3) & 1, lds);
            else {
                unsigned* cnt = (unsigned*)(a.ws + WS_CNT) + 64 * l;
                const int vb = bid - 64, nvb = G - 64, nprod = nvb < 64 ? nvb : 64;
                gla_prefix(a, vb, nvb);
                asm volatile("s_waitcnt vmcnt(0)" ::: "memory");
                __syncthreads();
                if (threadIdx.x == 0) {
                    if (vb < nprod) { __builtin_amdgcn_fence(__ATOMIC_RELEASE, "agent"); asm volatile("s_waitcnt vmcnt(0)" ::: "memory"); (void)xb_add(cnt, 1u); }
                    unsigned sp = 0;
                    while (xb_ld(cnt) < (unsigned)nprod) { __builtin_amdgcn_s_sleep(4); if (++sp > (1u << 24)) break; }
                    __builtin_amdgcn_fence(__ATOMIC_ACQUIRE, "agent"); asm volatile("s_waitcnt vmcnt(0)" ::: "memory");
                }
                __syncthreads();
                out_phase<64>(a, l, true, vb, nvb, lds);
                if (l == 0) { const int tt = otid(); convert_weights(a, 1, vb * 8 + (tt >> 6), nvb * 8, (float*)(lds + (tt >> 6) * 8448), tt & 63); }
            }
        PHASE_END
        PHASE_BEGIN
            out_phase<128>(a, l, false, bid, G, lds);
        PHASE_END
        PHASE_BEGIN {
            pg8::Gemm g{(const bf16_t*)(a.ws + WS_O), (const bf16_t*)(a.ws + WS_WOUT + l * WOUT_BYTES), MROWS, DM, DM};
            pg8::StaticOrder S; S.init(MROWS, DM, G, bid);
            EpiOutLN E{resid, a.out, l == 0 ? (bf16_t*)(a.ws + WS_XB) : nullptr, a.ln_g + l * DM, a.ln_b + l * DM, (unsigned*)(a.ws + WS_XBUF), (unsigned*)(a.ws + WS_LNCNT) + l * 4096};
            pg8::gemm_phase<EpiOutLN>((LAS unsigned char*)lds, g, S, E);
        } PHASE_END
    }
}
constexpr int NPHASE = 11;

extern "C" void kernel_launch(void* const* d_in, const int* in_sizes, int n_in, void* d_out, int out_size,
                              void* d_ws, size_t ws_size, hipStream_t stream) {
    static int grid = 0;
    if (grid == 0) {
        int dev = 0, cus = 0, per_cu = 0;
        (void)hipGetDevice(&dev);
        (void)hipDeviceGetAttribute(&cus, hipDeviceAttributeMultiprocessorCount, dev);
        (void)hipFuncSetAttribute((const void*)mk_fwd, hipFuncAttributeMaxDynamicSharedMemorySize, LDS_BYTES);
        (void)hipOccupancyMaxActiveBlocksPerMultiprocessor(&per_cu, (const void*)mk_fwd, 512, LDS_BYTES);
        if (per_cu < 1) { fprintf(stderr, "kernel_launch: occupancy query reports %d blocks per CU\n", per_cu); }
        grid = cus > 0 ? cus : 256;
        if (ws_size < WS_END) { fprintf(stderr, "kernel_launch: workspace too small: %zu < %zu\n", ws_size, (size_t)WS_END); grid = -1; }
    }
    if (grid < 0) return;
    Args a{};
    a.x = (const float*)d_in[0]; a.w_in = (const float*)d_in[1]; a.conv_w = (const float*)d_in[2]; a.a_log = (const float*)d_in[3];
    a.dt_bias = (const float*)d_in[4]; a.gw2 = (const float*)d_in[5]; a.gb = (const float*)d_in[6]; a.dn_g = (const float*)d_in[7];
    a.gla_g = (const float*)d_in[8]; a.w_out = (const float*)d_in[9]; a.ln_g = (const float*)d_in[10]; a.ln_b = (const float*)d_in[11];
    a.out = (float*)d_out; a.ws = (unsigned char*)d_ws;
#ifndef MK_LAUNCHES
#define MK_LAUNCHES 1
#endif
    (void)hipMemsetAsync((char*)d_ws + WS_BAR, 0, 65536, stream);
    for (int li = 0; li < MK_LAUNCHES; ++li) {
        a.ph_lo = MK_LAUNCHES == 1 ? 0 : li; a.ph_hi = MK_LAUNCHES == 1 ? NPHASE : li + 1;
        void* args[] = {&a};
        hipError_t e = hipLaunchCooperativeKernel((const void*)mk_fwd, dim3(grid), dim3(512), args, LDS_BYTES, stream);
        if (e != hipSuccess) { fprintf(stderr, "cooperative launch failed: %s\n", hipGetErrorString(e)); break; }
    }
}
```

```cpp
#include <hip/hip_runtime.h>
#include <hip/hip_cooperative_groups.h>
#include <cstdio>
namespace cg = cooperative_groups;

#define LAS __attribute__((address_space(3)))
typedef unsigned short bf16_t;
typedef short bf16x8 __attribute__((ext_vector_type(8)));
typedef float f32x4 __attribute__((ext_vector_type(4)));
typedef unsigned u32x4 __attribute__((ext_vector_type(4)));
typedef unsigned u32x2 __attribute__((ext_vector_type(2)));

constexpr int SEQ = 2048, DM = 1024, MROWS = 16384, NPROJ = 3840, NTASK = 1024;
constexpr float DEEP_ALPHA = 1.41421356237f, EPS = 1e-6f;
constexpr size_t MiB = 1u << 20;
constexpr size_t WS_EGL = 0, WS_EBL = 65536, WS_SMALL = 1 * MiB, WS_WIN = 3 * MiB, WS_WOUT = 18 * MiB, WS_XB = 22 * MiB;
constexpr size_t WS_NEGW = 22 * MiB, WS_KDT = 38 * MiB;
constexpr size_t WS_DNZ = 54 * MiB, WS_GZ = 70 * MiB;
constexpr size_t WS_DNQ = 86 * MiB, WS_DNK = 102 * MiB, WS_DNV = 118 * MiB, WS_GQ = 134 * MiB, WS_GK = 142 * MiB, WS_GV = 150 * MiB;
constexpr size_t WS_DNST = 86 * MiB;
constexpr size_t WS_UT = 166 * MiB, WS_DQT = 182 * MiB, WS_DATT = 198 * MiB, WS_GQT = 206 * MiB, WS_GATT = 214 * MiB, WS_GVT = 222 * MiB, WS_GST = 238 * MiB;
constexpr size_t WS_Y = 166 * MiB, WS_END = 255 * MiB;
constexpr size_t WS_O = 118 * MiB;
constexpr size_t WS_CNT = 540672, WS_LNCNT = 544768, WS_XBUF = 254 * MiB;
constexpr size_t WIN_BYTES = (size_t)NPROJ * DM * 2, WOUT_BYTES = (size_t)DM * DM * 2;

typedef _Float16 h16x2 __attribute__((ext_vector_type(2)));
typedef _Float16 h16x8 __attribute__((ext_vector_type(8)));
__device__ __forceinline__ unsigned f2bf(float f) { return (unsigned)__builtin_bit_cast(unsigned short, (_Float16)f); }
__device__ __forceinline__ unsigned pk2(float lo, float hi) { h16x2 v = {(_Float16)lo, (_Float16)hi}; return __builtin_bit_cast(unsigned, v); }
__device__ __forceinline__ unsigned pkh2(float lo, float hi) { return pk2(lo, hi); }
__device__ __forceinline__ float bflo(unsigned w) { return (float)__builtin_bit_cast(h16x2, w).x; }
__device__ __forceinline__ float bfhi(unsigned w) { return (float)__builtin_bit_cast(h16x2, w).y; }
__device__ __forceinline__ float hlo(unsigned w) { return bflo(w); }
__device__ __forceinline__ float hhi(unsigned w) { return bfhi(w); }
__device__ __forceinline__ float h1f(bf16_t h) { return (float)__builtin_bit_cast(_Float16, h); }
__device__ __forceinline__ float bf1(bf16_t h) { return h1f(h); }
__device__ __forceinline__ bf16x8 pack8(f32x4 a, f32x4 b) { u32x4 w; w.x = pk2(a[0], a[1]); w.y = pk2(a[2], a[3]); w.z = pk2(b[0], b[1]); w.w = pk2(b[2], b[3]); return __builtin_bit_cast(bf16x8, w); }
__device__ __forceinline__ void unpack8(u32x4 w, float* o) { o[0] = bflo(w.x); o[1] = bfhi(w.x); o[2] = bflo(w.y); o[3] = bfhi(w.y); o[4] = bflo(w.z); o[5] = bfhi(w.z); o[6] = bflo(w.w); o[7] = bfhi(w.w); }
__device__ __forceinline__ void unpackh8(u32x4 w, float* o) { unpack8(w, o); }
__device__ __forceinline__ f32x4 mfma16(bf16x8 a, bf16x8 b, f32x4 c) { return __builtin_amdgcn_mfma_f32_16x16x32_f16(__builtin_bit_cast(h16x8, a), __builtin_bit_cast(h16x8, b), c, 0, 0, 0); }
__device__ __forceinline__ unsigned pki2(float lo, float hi) { const int a = (int)rintf(fminf(fmaxf(lo * 4096.f, -32767.f), 32767.f)), b = (int)rintf(fminf(fmaxf(hi * 4096.f, -32767.f), 32767.f)); return ((unsigned)a & 0xffffu) | ((unsigned)b << 16); }
__device__ __forceinline__ void unpacki8(u32x4 w, float* o) { const unsigned ww[4] = {w.x, w.y, w.z, w.w};
#pragma unroll
    for (int e = 0; e < 4; ++e) { o[2 * e] = (float)(short)(ww[e] & 0xffffu); o[2 * e + 1] = (float)(short)(ww[e] >> 16); } }
__device__ __forceinline__ float siluf(float x) { return x * __builtin_amdgcn_rcpf(1.f + __expf(-x)); }
__device__ __forceinline__ int il(int t, int m) { return 8 * (m >> 2) + 4 * t + (m & 3); }

constexpr float LO_SCALE = 2048.f;
__device__ __forceinline__ void split8(const float* v, u32x4& hi, u32x4& lo) {
    float r[8]; unsigned h[8];
#pragma unroll
    for (int e = 0; e < 8; ++e) { const _Float16 hh = (_Float16)v[e]; h[e] = (unsigned)__builtin_bit_cast(unsigned short, hh); r[e] = (v[e] - (float)hh) * LO_SCALE; }
    hi.x = h[0] | (h[1] << 16); hi.y = h[2] | (h[3] << 16); hi.z = h[4] | (h[5] << 16); hi.w = h[6] | (h[7] << 16);
    lo.x = pk2(r[0], r[1]); lo.y = pk2(r[2], r[3]); lo.z = pk2(r[4], r[5]); lo.w = pk2(r[6], r[7]);
}
__device__ __forceinline__ void lds_barrier() { asm volatile("s_waitcnt lgkmcnt(0)" ::: "memory"); __builtin_amdgcn_s_barrier(); asm volatile("" ::: "memory"); }
#define SCHED_FENCE() __builtin_amdgcn_sched_barrier(0)
__device__ __forceinline__ int otid() { int t = threadIdx.x; asm volatile("" : "+v"(t)); return t; }
namespace pg8 {
constexpr int BM = 256, BK = 64, HALF = 128, HTB = HALF * BK * 2, STAGE_BYTES = 8 * HTB, NXCD = 8, WGM = 4;
__device__ __forceinline__ int lds_byte(int r, int c) { const int st = (r >> 4) * 2 + (c >> 5), rr = r & 15, cc = c & 31, ob = rr * 64 + cc * 2; return st * 1024 + (ob ^ (((ob >> 9) & 1) << 5)); }
__device__ __forceinline__ void stage_rc(int b, int& R, int& C) { const int st = b / 1024, sb = b % 1024, swz = sb ^ (((sb >> 9) & 1) << 5); R = (st >> 1) * 16 + swz / 64; C = (st & 1) * 32 + (swz % 64) / 2; }
__device__ __forceinline__ int perm32(int rho) { const int n = rho >> 4, i = rho & 15; return 8 * (i >> 2) + 4 * n + (i & 3); }
struct Unit { int pm, pn; };
struct Gemm { const bf16_t* A; const bf16_t* Bt; int M, N, K; };
struct StaticOrder {
    int nM, nN, nwg, G, c;
    __device__ void init(int M, int N, int G_, int c_) { nM = M / BM; nN = N / BM; nwg = nM * nN; G = G_; c = c_; }
    __device__ bool next(int i, Unit& u) const {
        const long L = (long)i * G + c; if (L >= nwg) return false;
        int wgid = (int)L; { const int q = nwg / NXCD, r = nwg % NXCD, xcd = wgid % NXCD, off = wgid / NXCD; wgid = (xcd < r ? xcd * (q + 1) : r * (q + 1) + (xcd - r) * q) + off; }
        const int nig = WGM * nN, gid = wgid / nig, fm = gid * WGM, gsz = (nM - fm) < WGM ? (nM - fm) : WGM;
        u.pm = fm + ((wgid % nig) % gsz); u.pn = (wgid % nig) / gsz; return true;
    }
};

template <class Epi>
__device__ __forceinline__ void gemm_phase(LAS unsigned char* lds, const Gemm g, const StaticOrder& S, const Epi& E) {
    const int tid = otid(), wid = __builtin_amdgcn_readfirstlane(tid >> 6), lane = tid & 63, wr = wid >> 2, wc = wid & 3, fr = lane & 15, fq = lane >> 4;
    const int K = g.K, nt = K / BK;
    unsigned voffA[2], voffB[2];
#pragma unroll
    for (int i = 0; i < 2; ++i) { int R, C; stage_rc(tid * 16 + i * 8192, R, C); const int Rb = Epi::PERM ? ((R & ~31) + perm32(R & 31)) : R;
        voffA[i] = (unsigned)(R * K + C) * 2u; voffB[i] = (unsigned)(Rb * K + C) * 2u; }
    const size_t kstep = (size_t)(BK * 2);
    const size_t hstep = (size_t)HALF * K * 2;
    const size_t tstep = 2 * hstep;
    const unsigned ldsw = (unsigned)wid * 1024u;
    const int aoff = lds_byte(wr * 64 + fr, fq * 8), boff = lds_byte(wc * 32 + fr, fq * 8);
#define PG8_SA(b, h) (((b) * 2 + (h)) * HTB)
#define PG8_SB(b, h) ((4 + (b) * 2 + (h)) * HTB)
#define PG8_STAGE(bufoff, gbase, voff) do { _Pragma("unroll") for (int _i = 0; _i < 2; ++_i) \
        __builtin_amdgcn_global_load_lds((const unsigned*)((const char*)(gbase) + (voff)[_i]), (LAS unsigned*)(lds + (bufoff) + ldsw + _i * 8192), 16, 0, 0); } while (0)
#define PG8_LDA(dst, b, h) do { _Pragma("unroll") for (int m = 0; m < 4; ++m) _Pragma("unroll") for (int k = 0; k < 2; ++k) dst[m][k] = *(const LAS bf16x8*)(lds + PG8_SA(b, h) + aoff + m * 2048 + k * 1024); } while (0)
#define PG8_LDB(dst, b, h) do { _Pragma("unroll") for (int n = 0; n < 2; ++n) _Pragma("unroll") for (int k = 0; k < 2; ++k) dst[n][k] = *(const LAS bf16x8*)(lds + PG8_SB(b, h) + boff + n * 2048 + k * 1024); } while (0)
#define PG8_MMA(ai, bj, At, Bt) do { __builtin_amdgcn_s_setprio(1); _Pragma("unroll") for (int m = 0; m < 4; ++m) _Pragma("unroll") for (int n = 0; n < 2; ++n) _Pragma("unroll") for (int k = 0; k < 2; ++k) \
        acc[ai][bj][m][n] = __builtin_amdgcn_mfma_f32_16x16x32_f16(__builtin_bit_cast(h16x8, Bt[n][k]), __builtin_bit_cast(h16x8, At[m][k]), acc[ai][bj][m][n], 0, 0, 0); __builtin_amdgcn_s_setprio(0); } while (0)
#define PG8_WAIT_V(n) asm volatile("s_waitcnt vmcnt(" #n ")" ::: "memory")
#define PG8_WAIT_L(n) asm volatile("s_waitcnt lgkmcnt(" #n ")" ::: "memory")
#define PG8_BAR __builtin_amdgcn_s_barrier()
#define PG8_SCHED __builtin_amdgcn_sched_barrier(0)
    Unit cur, nxt; int ui = 0;
    if (!S.next(0, cur)) return;
    f32x4 acc[2][2][4][2];
#pragma unroll
    for (int a = 0; a < 2; ++a)
#pragma unroll
        for (int b = 0; b < 2; ++b)
#pragma unroll
            for (int m = 0; m < 4; ++m)
#pragma unroll
                for (int n = 0; n < 2; ++n) acc[a][b][m][n] = (f32x4){0.f, 0.f, 0.f, 0.f};
    bf16x8 At[4][2], B0[2][2], B1[2][2];
    const char* cA = (const char*)g.A + (size_t)cur.pm * tstep; const char* cB = (const char*)g.Bt + (size_t)cur.pn * tstep;
    PG8_STAGE(PG8_SB(0, 0), cB, voffB); PG8_STAGE(PG8_SA(0, 0), cA, voffA); PG8_STAGE(PG8_SB(0, 1), cB + hstep, voffB); PG8_STAGE(PG8_SA(0, 1), cA + hstep, voffA);
    if (wr == 1) PG8_BAR;
    PG8_WAIT_V(4); PG8_BAR;
    PG8_STAGE(PG8_SB(1, 0), cB + kstep, voffB); PG8_STAGE(PG8_SA(1, 0), cA + kstep, voffA); PG8_STAGE(PG8_SB(1, 1), cB + hstep + kstep, voffB);
    PG8_WAIT_V(6); PG8_BAR;
    for (;;) {
        const bool has_next = S.next(ui + 1, nxt);
        const char* nA = has_next ? (const char*)g.A + (size_t)nxt.pm * tstep : cA; const char* nB = has_next ? (const char*)g.Bt + (size_t)nxt.pn * tstep : cB;
        for (int t = 0; t < nt; t += 2) {
            const bool last = (t == nt - 2);
            const char* a1 = cA + (size_t)(t + 1) * kstep;
            const char* a2 = last ? nA : cA + (size_t)(t + 2) * kstep; const char* b2 = last ? nB : cB + (size_t)(t + 2) * kstep;
            const char* a3 = a2 + kstep; const char* b3 = b2 + kstep;
            PG8_LDB(B0, 0, 0); PG8_SCHED; PG8_LDA(At, 0, 0); PG8_STAGE(PG8_SA(1, 1), a1 + hstep, voffA);
            PG8_WAIT_L(8); PG8_BAR; PG8_WAIT_L(0); PG8_MMA(0, 0, At, B0); PG8_BAR; PG8_SCHED;
            PG8_LDB(B1, 0, 1); PG8_STAGE(PG8_SB(0, 0), b2, voffB);
            PG8_BAR; PG8_WAIT_L(0); PG8_MMA(0, 1, At, B1); PG8_BAR;
            PG8_LDA(At, 0, 1); PG8_STAGE(PG8_SA(0, 0), a2, voffA);
            PG8_BAR; PG8_WAIT_L(0); PG8_MMA(1, 0, At, B0); PG8_BAR; PG8_SCHED;
            PG8_STAGE(PG8_SB(0, 1), b2 + hstep, voffB);
            PG8_WAIT_V(6); PG8_BAR; PG8_MMA(1, 1, At, B1); PG8_BAR;
            PG8_LDB(B0, 1, 0); PG8_SCHED; PG8_LDA(At, 1, 0); PG8_STAGE(PG8_SA(0, 1), a2 + hstep, voffA);
            PG8_WAIT_L(8); PG8_BAR; PG8_WAIT_L(0); PG8_MMA(0, 0, At, B0); PG8_BAR; PG8_SCHED;
            PG8_LDB(B1, 1, 1); PG8_STAGE(PG8_SB(1, 0), b3, voffB);
            PG8_BAR; PG8_WAIT_L(0); PG8_MMA(0, 1, At, B1); PG8_BAR;
            PG8_LDA(At, 1, 1); PG8_STAGE(PG8_SA(1, 0), a3, voffA);
            PG8_BAR; PG8_WAIT_L(0); PG8_MMA(1, 0, At, B0); PG8_BAR; PG8_SCHED;
            PG8_STAGE(PG8_SB(1, 1), b3 + hstep, voffB);
            PG8_WAIT_V(6); PG8_BAR; PG8_MMA(1, 1, At, B1); PG8_BAR;
        }
        if constexpr (!Epi::AFTER_DRAIN) E(acc, cur, wr, wc, fr, fq);
        if (!has_next) break;
#pragma unroll
        for (int a = 0; a < 2; ++a)
#pragma unroll
            for (int b = 0; b < 2; ++b)
#pragma unroll
                for (int m = 0; m < 4; ++m)
#pragma unroll
                    for (int n = 0; n < 2; ++n) acc[a][b][m][n] = (f32x4){0.f, 0.f, 0.f, 0.f};
        cur = nxt; cA = nA; cB = nB; ++ui;
    }
    PG8_WAIT_V(0);
    if (wr == 0) PG8_BAR;
    PG8_BAR;
    if constexpr (Epi::AFTER_DRAIN) E.fused(acc, cur, wr, wc, fr, fq, lds, wid, lane);
#undef PG8_SA
#undef PG8_SB
#undef PG8_STAGE
#undef PG8_LDA
#undef PG8_LDB
#undef PG8_MMA
#undef PG8_WAIT_V
#undef PG8_WAIT_L
#undef PG8_BAR
#undef PG8_SCHED
}
}

struct EpiProj {
    static constexpr bool PERM = true, AFTER_DRAIN = false;
    unsigned char* ws;
    __device__ __forceinline__ void operator()(const f32x4 (&acc)[2][2][4][2], const pg8::Unit& u, int wr, int wc, int fr, int fq) const {
        const int pn = u.pn; const int row0 = u.pm * 256 + wr * 64 + fr;
        if (pn < 14) {
            size_t off; int ldc, colt;
            if (pn < 8) { off = (pn >> 1) == 3 ? WS_DNZ : WS_DNQ + (size_t)(pn >> 1) * 16 * MiB; ldc = 512; colt = (pn & 1) * 256; }
            else if (pn == 8) { off = WS_GQ; ldc = 256; colt = 0; }
            else if (pn == 9) { off = WS_GK; ldc = 256; colt = 0; }
            else if (pn < 12) { off = WS_GV; ldc = 512; colt = (pn - 10) * 256; }
            else { off = WS_GZ; ldc = 512; colt = (pn - 12) * 256; }
            bf16_t* base = (bf16_t*)(ws + off);
            const int col0 = colt + wc * 32 + 8 * fq;
#pragma unroll
            for (int ai = 0; ai < 2; ++ai)
#pragma unroll
                for (int m = 0; m < 4; ++m) { bf16_t* rowp = base + (size_t)(row0 + ai * 128 + m * 16) * ldc + col0;
#pragma unroll
                    for (int bj = 0; bj < 2; ++bj) { const f32x4 v0 = acc[ai][bj][m][0], v1 = acc[ai][bj][m][1];
                        u32x4 w;
                        if (pn < 4) { w.x = pki2(v0[0], v0[1]); w.y = pki2(v0[2], v0[3]); w.z = pki2(v1[0], v1[1]); w.w = pki2(v1[2], v1[3]); }
                        else { w.x = pkh2(v0[0], v0[1]); w.y = pkh2(v0[2], v0[3]); w.z = pkh2(v1[0], v1[1]); w.w = pkh2(v1[2], v1[3]); }
                        *(u32x4*)(rowp + bj * 128) = w; } }
        } else if (wc == 0) {
            float* sm = (float*)(ws + WS_SMALL);
#pragma unroll
            for (int ai = 0; ai < 2; ++ai)
#pragma unroll
                for (int m = 0; m < 4; ++m) { float* rowp = sm + (size_t)(row0 + ai * 128 + m * 16) * 32 + 8 * fq;
                    *(f32x4*)(rowp) = acc[ai][0][m][0]; *(f32x4*)(rowp + 4) = acc[ai][0][m][1]; }
        }
    }
};
struct EpiOutLN {
    static constexpr bool PERM = false, AFTER_DRAIN = true;
    const float* resid; float* out; bf16_t* xb; const float* lng; const float* lnb; unsigned* xbuf; unsigned* cnt;
    __device__ __forceinline__ void operator()(const f32x4 (&)[2][2][4][2], const pg8::Unit&, int, int, int, int) const {}
    __device__ __forceinline__ void fused(f32x4 (&acc)[2][2][4][2], const pg8::Unit& u, int wr, int wc, int fr, int fq, LAS unsigned char* lds, int wid, int lane) const {
        typedef float f32x2v __attribute__((ext_vector_type(2)));
        LAS f32x2v* P = (LAS f32x2v*)lds;
        LAS f32x2v* S = (LAS f32x2v*)(lds + 8192);
        const int col0 = u.pn * 256 + wc * 32 + 4 * fq;
        f32x4 rb[2][4];
#pragma unroll
        for (int i = 0; i < 4; ++i) rb[0][i] = __builtin_nontemporal_load((const f32x4*)(resid + (size_t)(u.pm * 256 + wr * 64 + fr) * DM + col0 + (i >> 1) * 128 + (i & 1) * 16));
#pragma unroll
        for (int g = 0; g < 8; ++g) {
            const int ai = g >> 2, m = g & 3;
            if (g + 1 < 8) { const int ai1 = (g + 1) >> 2, m1 = (g + 1) & 3; const size_t off1 = (size_t)(u.pm * 256 + ai1 * 128 + wr * 64 + m1 * 16 + fr) * DM + col0;
#pragma unroll
                for (int i = 0; i < 4; ++i) rb[(g + 1) & 1][i] = __builtin_nontemporal_load((const f32x4*)(resid + off1 + (i >> 1) * 128 + (i & 1) * 16)); }
#pragma unroll
            for (int i = 0; i < 4; ++i) acc[ai][i >> 1][m][i & 1] = rb[g & 1][i] * DEEP_ALPHA + acc[ai][i >> 1][m][i & 1];
            asm volatile("" : "+v"(acc[ai][0][m][0]), "+v"(acc[ai][0][m][1]), "+v"(acc[ai][1][m][0]), "+v"(acc[ai][1][m][1]));
            SCHED_FENCE();
        }
#pragma unroll
        for (int ai = 0; ai < 2; ++ai)
#pragma unroll
            for (int m = 0; m < 4; ++m) {
                float s = 0.f;
#pragma unroll
                for (int bj = 0; bj < 2; ++bj)
#pragma unroll
                    for (int n = 0; n < 2; ++n) { const f32x4 x = acc[ai][bj][m][n]; s += (x[0] + x[1]) + (x[2] + x[3]); }
                s += __shfl_xor(s, 16); s += __shfl_xor(s, 32);
                const float mw = s * (1.0f / 64.0f); float qq = 0.f;
#pragma unroll
                for (int bj = 0; bj < 2; ++bj)
#pragma unroll
                    for (int n = 0; n < 2; ++n) { const f32x4 d = acc[ai][bj][m][n] - mw; qq += (d[0] * d[0] + d[1] * d[1]) + (d[2] * d[2] + d[3] * d[3]); }
                qq += __shfl_xor(qq, 16); qq += __shfl_xor(qq, 32);
                if (fq == 0) P[(ai * 128 + wr * 64 + m * 16 + fr) * 4 + wc] = (f32x2v){mw, qq};
            }
        asm volatile("s_waitcnt lgkmcnt(0)" ::: "memory"); __builtin_amdgcn_s_barrier(); asm volatile("" ::: "memory");
        const int row = wid * 32 + (lane & 31);
        if (lane < 32) {
            const f32x2v pa = P[row * 4 + 0], pb = P[row * 4 + 1], pc = P[row * 4 + 2], pd = P[row * 4 + 3];
            const float mt = (pa.x + pb.x + pc.x + pd.x) * 0.25f;
            const float da = pa.x - mt, db = pb.x - mt, dc = pc.x - mt, dd = pd.x - mt;
            const float m2 = (pa.y + pb.y) + (pc.y + pd.y) + 64.0f * ((da * da + db * db) + (dc * dc + dd * dd));
            unsigned long long* slot = (unsigned long long*)xbuf + ((size_t)(u.pm * 256 + row) * 4 + u.pn);
            __hip_atomic_store(slot, ((unsigned long long)__float_as_uint(m2) << 32) | __float_as_uint(mt), __ATOMIC_RELAXED, __HIP_MEMORY_SCOPE_AGENT);
        }
        asm volatile("s_waitcnt vmcnt(0)" ::: "memory");
        if (lane == 0) __hip_atomic_fetch_add(cnt + 64 * u.pm, 1u, __ATOMIC_RELAXED, __HIP_MEMORY_SCOPE_AGENT);
        if (wid == 0) {
            unsigned sp = 0;
            while ((unsigned)__builtin_amdgcn_readfirstlane(__hip_atomic_load(cnt + 64 * u.pm, __ATOMIC_RELAXED, __HIP_MEMORY_SCOPE_AGENT)) < 32u) { __builtin_amdgcn_s_sleep(2); if (++sp > (1u << 24)) break; }
            __builtin_amdgcn_fence(__ATOMIC_ACQUIRE, "agent");
        }
        asm volatile("s_waitcnt vmcnt(0) lgkmcnt(0)" ::: "memory"); __builtin_amdgcn_s_barrier(); asm volatile("" ::: "memory");
        if (lane < 32) {
            const unsigned long long* slot = (const unsigned long long*)xbuf + (size_t)(u.pm * 256 + row) * 4; float mt[4], m2[4]; float ms = 0.f;
#pragma unroll
            for (int t = 0; t < 4; ++t) { const unsigned long long wv = __hip_atomic_load(slot + t, __ATOMIC_RELAXED, __HIP_MEMORY_SCOPE_AGENT); mt[t] = __uint_as_float((unsigned)wv); m2[t] = __uint_as_float((unsigned)(wv >> 32)); ms += mt[t]; }
            const float mean = ms * 0.25f; float qq = 0.f;
#pragma unroll
            for (int t = 0; t < 4; ++t) { const float dm = mt[t] - mean; qq += m2[t] + 256.0f * dm * dm; }
            S[row] = (f32x2v){mean, rsqrtf(qq * (1.0f / 1024.0f) + EPS)};
        }
        asm volatile("s_waitcnt lgkmcnt(0)" ::: "memory"); __builtin_amdgcn_s_barrier(); asm volatile("" ::: "memory");
#pragma unroll
        for (int ai = 0; ai < 2; ++ai)
#pragma unroll
            for (int m = 0; m < 4; ++m) { const int r = ai * 128 + wr * 64 + m * 16 + fr; const f32x2v sr = S[r]; const size_t off = (size_t)(u.pm * 256 + r) * DM + col0;
#pragma unroll
                for (int bj = 0; bj < 2; ++bj)
#pragma unroll
                    for (int n = 0; n < 2; ++n) { const f32x4 gg = *(const f32x4*)(lng + col0 + bj * 128 + n * 16), bb = *(const f32x4*)(lnb + col0 + bj * 128 + n * 16);
                        const f32x4 o = (acc[ai][bj][m][n] - sr.x) * sr.y * gg + bb;
                        *(f32x4*)(out + off + bj * 128 + n * 16) = o;
                        if (xb) { u32x2 wv; wv.x = pkh2(o[0], o[1]); wv.y = pkh2(o[2], o[3]); *(u32x2*)(xb + off + bj * 128 + n * 16) = wv; } }
                SCHED_FENCE(); }
    }
};

#define XB_TMO      128
#define XB_XCNT(j)  (256  + 64 * (j))
#define XB_XSUB(j)  (1280 + 64 * (j))
#define XB_XGEN(j)  (2304 + 64 * (j))
#define XB_TOP      3328
#define XB_TOPGEN   3392
#define XCD_BAR_WORDS 3456
#define XB_SPIN_CAP (1u << 22)
__device__ __forceinline__ unsigned xb_ld(unsigned* p)              { return __hip_atomic_load(p, __ATOMIC_RELAXED, __HIP_MEMORY_SCOPE_AGENT); }
__device__ __forceinline__ unsigned xb_add(unsigned* p, unsigned v) { return __hip_atomic_fetch_add(p, v, __ATOMIC_RELAXED, __HIP_MEMORY_SCOPE_AGENT); }
__device__ __forceinline__ unsigned xb_xcc_id() { return (unsigned)__builtin_amdgcn_s_getreg((3 << 11) | 20) & 0xFu; }
#define XB_SPIN(cond, bar) do { unsigned _sp = 0; while (cond) { __builtin_amdgcn_s_sleep(4); \
    if ((++_sp & 255u) == 0u) { if (xb_ld(&(bar)[XB_TMO])) break; if (_sp > XB_SPIN_CAP) { atomicAdd(&(bar)[XB_TMO], 1u); break; } } } } while (0)
struct XcdBarrier { unsigned* bar; unsigned x; volatile LAS unsigned* st; };
__device__ __forceinline__ XcdBarrier xcd_barrier_post(unsigned* bar, volatile LAS unsigned* st) {
    XcdBarrier b; b.bar = bar; b.x = xb_xcc_id(); b.st = st;
    if (threadIdx.x == 0) (void)xb_add(&bar[XB_XCNT(b.x)], 1u);
    return b;
}
__device__ __forceinline__ void xcd_barrier_complete(unsigned* bar, unsigned x, unsigned& nloc, unsigned& nx) {
    const unsigned G = gridDim.x * gridDim.y * gridDim.z;
    unsigned sum, cnt, mine, sp = 0u;
    for (;;) {
        sum = 0u; cnt = 0u; mine = 0u;
#pragma unroll
        for (unsigned j = 0; j < 16; ++j) { const unsigned c = xb_ld(&bar[XB_XCNT(j)]); sum += c; cnt += (c > 0u) ? 1u : 0u; mine = (j == x) ? c : mine; }
        if (sum == G) break;
        __builtin_amdgcn_s_sleep(1);
        if ((++sp & 255u) == 0u) { if (xb_ld(&bar[XB_TMO])) break; if (sp > XB_SPIN_CAP) { atomicAdd(&bar[XB_TMO], 1u); break; } }
    }
    nloc = mine > 0u ? mine : 1u; nx = cnt > 0u ? cnt : 1u;
}
__device__ __forceinline__ void xcd_barrier(const XcdBarrier& b) {
    asm volatile("s_waitcnt vmcnt(0)" ::: "memory");
    __syncthreads();
    if (threadIdx.x == 0) {
        unsigned* bar = b.bar;
        __builtin_amdgcn_s_waitcnt(0);
        unsigned nloc = b.st[0], nx = b.st[1];
        if (nloc == 0u) { xcd_barrier_complete(bar, b.x, nloc, nx); b.st[0] = nloc; b.st[1] = nx; }
        const unsigned old = xb_add(&bar[XB_XSUB(b.x)], 1u);
        const unsigned gen = old / nloc;
        if (old + 1u == (gen + 1u) * nloc) {
            __builtin_amdgcn_fence(__ATOMIC_RELEASE, "agent");
            asm volatile("s_waitcnt vmcnt(0)" ::: "memory");
            const unsigned og = xb_add(&bar[XB_TOP], 1u);
            const unsigned tg = og / nx;
            if (og + 1u == (tg + 1u) * nx) xb_add(&bar[XB_TOPGEN], 1u);
            else XB_SPIN(xb_ld(&bar[XB_TOPGEN]) == tg, bar);
            __builtin_amdgcn_fence(__ATOMIC_ACQUIRE, "agent");
            xb_add(&bar[XB_XGEN(b.x)], 1u);
            asm volatile("s_waitcnt vmcnt(0)" ::: "memory");
        } else {
            XB_SPIN(xb_ld(&bar[XB_XGEN(b.x)]) == gen, bar);
            __builtin_amdgcn_fence(__ATOMIC_ACQUIRE, "agent");
            asm volatile("s_waitcnt vmcnt(0)" ::: "memory");
        }
    }
    __syncthreads();
}
constexpr size_t WS_BAR = 524288;

struct Args {
    const float *x, *w_in, *conv_w, *a_log, *dt_bias, *gw2, *gb, *dn_g, *gla_g, *w_out, *ln_g, *ln_b;
    float* out; unsigned char* ws; int ph_lo, ph_hi;
};

__device__ __forceinline__ int win_src_col(int r) { return r < 2048 ? r : (r < 3584 ? r + 8 : (r < 3592 ? r - 1536 : (r < 3608 ? r : -1))); }
template <bool MAP>
__device__ __forceinline__ void transpose_item(const float* W, int ldw, bf16_t* WT, int nblk, float* scr, int item, int lane) {
    const int kb = item / nblk, nb = item % nblk, k0 = 64 * kb, n0 = 32 * nb;
    const int kk = lane >> 3, n4 = lane & 7;
    const int sc = MAP ? win_src_col(n0 + 4 * n4) : n0 + 4 * n4;
    f32x4 v[8];
#pragma unroll
    for (int i = 0; i < 8; ++i) v[i] = sc >= 0 ? __builtin_nontemporal_load((const f32x4*)(W + (size_t)(k0 + 8 * i + kk) * ldw + sc)) : (f32x4){0.f, 0.f, 0.f, 0.f};
#pragma unroll
    for (int i = 0; i < 8; ++i) { float* s = scr + (8 * i + kk) * 33 + 4 * n4; s[0] = v[i][0]; s[1] = v[i][1]; s[2] = v[i][2]; s[3] = v[i][3]; }
    asm volatile("s_waitcnt lgkmcnt(0)" ::: "memory");
    const int c = lane & 7;
#pragma unroll
    for (int j = 0; j < 4; ++j) { const int n = (lane >> 3) + 8 * j; const float* s = scr + (8 * c) * 33 + n;
        u32x4 o; o.x = pkh2(s[0 * 33], s[1 * 33]); o.y = pkh2(s[2 * 33], s[3 * 33]); o.z = pkh2(s[4 * 33], s[5 * 33]); o.w = pkh2(s[6 * 33], s[7 * 33]);
        *(u32x4*)(WT + (size_t)(n0 + n) * 1024 + k0 + 8 * c) = o; }
    asm volatile("s_waitcnt lgkmcnt(0)" ::: "memory");
}

__device__ __forceinline__ void convert_weights(const Args& a, int l, int gw, int ngw, float* scr, int lane) {
    constexpr int I_IN = 16 * (NPROJ / 32), I_OUT = 16 * 32;
    for (int r = gw; r < I_IN + I_OUT; r += ngw) {
        if (r < I_IN) transpose_item<true>(a.w_in + (size_t)l * DM * 3608, 3608, (bf16_t*)(a.ws + WS_WIN + l * WIN_BYTES), NPROJ / 32, scr, r, lane);
        else transpose_item<false>(a.w_out + (size_t)l * DM * DM, DM, (bf16_t*)(a.ws + WS_WOUT + l * WOUT_BYTES), 32, scr, r - I_IN, lane);
    }
}
__device__ __forceinline__ void prologue(const Args& a, unsigned char* lds) {
    const int tid = otid(), lane = tid & 63, wave = tid >> 6, G = gridDim.x;
    float* scr = (float*)(lds + wave * 8448);
    const int gw = blockIdx.x * 8 + wave, NGW = G * 8;
    convert_weights(a, 0, gw, NGW, scr, lane);
    const size_t n8 = (size_t)MROWS * DM / 8;
    u32x4* xb = (u32x4*)(a.ws + WS_XB);
    for (size_t i = (size_t)blockIdx.x * 512 + tid; i < n8; i += (size_t)G * 512) {
        const f32x4 v0 = __builtin_nontemporal_load((const f32x4*)a.x + 2 * i), v1 = __builtin_nontemporal_load((const f32x4*)a.x + 2 * i + 1);
        u32x4 w; w.x = pkh2(v0[0], v0[1]); w.y = pkh2(v0[2], v0[3]); w.z = pkh2(v1[0], v1[1]); w.w = pkh2(v1[2], v1[3]); xb[i] = w;
    }
}

constexpr int L_KS = 0, L_QS = 17408, L_RT = 34816, L_AF = 71680, L_TB = 89088, L_KD = 98304, L_SG = 116736, L_QL = 117248, L_KL = 134656, L_CW = 152064;
__device__ __forceinline__ void load5(const bf16_t* raw, int tloc, u32x4* rows) {
#pragma unroll
    for (int r = 0; r < 5; ++r) rows[r] = (tloc + r - 3 >= 0) ? *(const u32x4*)(raw + (ptrdiff_t)(r - 3) * 512) : (u32x4){0u, 0u, 0u, 0u};
}
template <bool I16>
__device__ __forceinline__ void conv2(const u32x4* rows, const float* cw, float* o0, float* o1) {
    float xr[5][8];
#pragma unroll
    for (int r = 0; r < 5; ++r) { if (I16) unpacki8(rows[r], xr[r]); else unpackh8(rows[r], xr[r]); }
#pragma unroll
    for (int e = 0; e < 8; ++e) { o0[e] = 0.f; o1[e] = 0.f; }
#pragma unroll
    for (int tap = 0; tap < 4; ++tap) {
        const f32x4 w0 = *(const f32x4*)(cw + tap * 128), w1 = *(const f32x4*)(cw + tap * 128 + 4);
#pragma unroll
        for (int e = 0; e < 4; ++e) { o0[e] += w0[e] * xr[tap][e]; o0[4 + e] += w1[e] * xr[tap][4 + e]; o1[e] += w0[e] * xr[tap + 1][e]; o1[4 + e] += w1[e] * xr[tap + 1][4 + e]; }
    }
#pragma unroll
    for (int e = 0; e < 8; ++e) { o0[e] = siluf(o0[e]); o1[e] = siluf(o1[e]); }
}
__device__ __forceinline__ float sum16(float v) { v += __shfl_xor(v, 1); v += __shfl_xor(v, 2); v += __shfl_xor(v, 4); v += __shfl_xor(v, 8); return v; }

struct DnPre { u32x4 rq[5]; float bl, al; };
__device__ __forceinline__ void dn_preload(const Args& a, int task, int tid, DnPre& p) {
    const int bh = task >> 5, n = task & 31, b = bh >> 2, h = bh & 3; const size_t tok0 = (size_t)b * SEQ + 64 * n;
    const int tp = tid >> 4, c = tid & 15, t0 = 2 * tp; const size_t ro = (tok0 + t0) * 512 + 128 * h + 8 * c;
    load5((const bf16_t*)(a.ws + WS_DNQ) + ro, 64 * n + t0, p.rq);
    if (tid < 64) { const float* sm = (const float*)(a.ws + WS_SMALL) + (tok0 + tid) * 32; p.bl = sm[h]; p.al = sm[4 + h]; }
}
__device__ __forceinline__ void dn_prep(const Args& a, int l, int task, int next, DnPre& P, float dtb, float nexpa, unsigned char* lds) {
    const int tid = otid(), lane = tid & 63, wave = __builtin_amdgcn_readfirstlane(tid >> 6), m = lane & 15, q = lane >> 4;
    const int bh = task >> 5, n = task & 31, b = bh >> 2, h = bh & 3;
    unsigned char* ws = a.ws;
    bf16_t* KS = (bf16_t*)(lds + L_KS); bf16_t* QS = (bf16_t*)(lds + L_QS); bf16_t* RT = (bf16_t*)(lds + L_RT);
    float* AF = (float*)(lds + L_AF); bf16_t* TB = (bf16_t*)(lds + L_TB); bf16_t* KD = (bf16_t*)(lds + L_KD); float* SG = (float*)(lds + L_SG);
    bf16_t* QL = (bf16_t*)(lds + L_QL); bf16_t* KL = (bf16_t*)(lds + L_KL);
    const size_t tok0 = (size_t)b * SEQ + 64 * n;
    u32x4 rq[5], rk[5], rv[5];
#pragma unroll
    for (int r = 0; r < 5; ++r) rq[r] = P.rq[r];
    { const int tp = tid >> 4, c = tid & 15, t0 = 2 * tp; const size_t ro = ((size_t)b * SEQ + 64 * n + t0) * 512 + 128 * h + 8 * c;
      load5((const bf16_t*)(ws + WS_DNK) + ro, 64 * n + t0, rk); load5((const bf16_t*)(ws + WS_DNV) + ro, 64 * n + t0, rv); }
    if (wave == 0) {
        const float bl = P.bl, al = P.al;
        const float beta = __builtin_amdgcn_rcpf(1.f + __expf(-bl));
        const float xs = al + dtb;
        const float ee = __expf(-fabsf(xs));
        const float l1p = ee < 0.03f ? ee * (1.f - ee * (0.5f - ee * 0.33333333f)) : __logf(1.f + ee);
        const float sp = fmaxf(xs, 0.f) + l1p;
        float g = nexpa * sp;
#pragma unroll
        for (int o = 1; o < 64; o <<= 1) { const float t = __shfl_up(g, o); if (lane >= o) g += t; }
        SG[lane] = g; SG[64 + lane] = beta;
    }
    lds_barrier();
    {
        const int tp = tid >> 4, c = tid & 15, t0 = 2 * tp;
        const float G0 = SG[t0], G1 = SG[t0 + 1], be0 = SG[64 + t0], be1 = SG[64 + t0 + 1], Gl = SG[63];
        const int tsw = 2 * (tp ^ (4 * (c & 7)));
        const float* cw = (const float*)(lds + L_CW) + 8 * c;
        float o0[8], o1[8];
        conv2<true>(rq, cw, o0, o1);
        {
            float s0 = 0.f, s1 = 0.f;
#pragma unroll
            for (int e = 0; e < 8; ++e) { s0 += o0[e] * o0[e]; s1 += o1[e] * o1[e]; }
            s0 = sum16(s0); s1 = sum16(s1);
            const float r0 = rsqrtf(s0 + EPS) * 0.08838834764831845f, r1 = rsqrtf(s1 + EPS) * 0.08838834764831845f;
            u32x4 w0, w1, g0, g1; const float e0 = __expf(G0) * 128.f, e1 = __expf(G1) * 128.f;
#pragma unroll
            for (int e = 0; e < 8; ++e) { o0[e] *= r0; o1[e] *= r1; }
            { u32x4 l0, l1; split8(o0, w0, l0); split8(o1, w1, l1); *(u32x4*)(QL + t0 * 136 + 8 * c) = l0; *(u32x4*)(QL + (t0 + 1) * 136 + 8 * c) = l1; }
            *(u32x4*)(QS + t0 * 136 + 8 * c) = w0; *(u32x4*)(QS + (t0 + 1) * 136 + 8 * c) = w1;
            g0.x = pk2(o0[0] * e0, o0[1] * e0); g0.y = pk2(o0[2] * e0, o0[3] * e0); g0.z = pk2(o0[4] * e0, o0[5] * e0); g0.w = pk2(o0[6] * e0, o0[7] * e0);
            g1.x = pk2(o1[0] * e1, o1[1] * e1); g1.y = pk2(o1[2] * e1, o1[3] * e1); g1.z = pk2(o1[4] * e1, o1[5] * e1); g1.w = pk2(o1[6] * e1, o1[7] * e1);
            bf16_t* qt = (bf16_t*)(ws + WS_DQT) + (size_t)task * 8192;
            *(u32x4*)(qt + t0 * 128 + 8 * c) = g0; *(u32x4*)(qt + (t0 + 1) * 128 + 8 * c) = g1;
        }
        conv2<true>(rk, cw + 512, o0, o1);
        {
            float s0 = 0.f, s1 = 0.f;
#pragma unroll
            for (int e = 0; e < 8; ++e) { s0 += o0[e] * o0[e]; s1 += o1[e] * o1[e]; }
            s0 = sum16(s0); s1 = sum16(s1);
            const float r0 = rsqrtf(s0 + EPS), r1 = rsqrtf(s1 + EPS);
#pragma unroll
            for (int e = 0; e < 8; ++e) { o0[e] *= r0; o1[e] *= r1; }
            u32x4 w0, w1;
            { u32x4 l0, l1; split8(o0, w0, l0); split8(o1, w1, l1); *(u32x4*)(KL + t0 * 136 + 8 * c) = l0; *(u32x4*)(KL + (t0 + 1) * 136 + 8 * c) = l1; }
            *(u32x4*)(KS + t0 * 136 + 8 * c) = w0; *(u32x4*)(KS + (t0 + 1) * 136 + 8 * c) = w1;
            const float kb0 = be0 * __expf(G0), kb1 = be1 * __expf(G1), kd0 = __expf(Gl - G0), kd1 = __expf(Gl - G1);
#pragma unroll
            for (int e = 0; e < 8; ++e) {
                *(unsigned*)(RT + (128 + 8 * c + e) * 72 + tsw) = pk2(o0[e] * kb0, o1[e] * kb1);
                *(unsigned*)(KD + (8 * c + e) * 72 + tsw) = pk2(o0[e] * kd0, o1[e] * kd1);
            }
        }
        conv2<false>(rv, cw + 1024, o0, o1);
#pragma unroll
        for (int e = 0; e < 8; ++e) *(unsigned*)(RT + (8 * c + e) * 72 + tsw) = pk2(o0[e] * be0, o1[e] * be1);
    }
    lds_barrier();
    if (next >= 0) dn_preload(a, next, tid, P);
    {
        bf16_t* att = (bf16_t*)(ws + WS_DATT) + (size_t)task * 4096;
        const int na = wave < 2 ? 2 : 1;
        for (int ja = 0; ja < na; ++ja) {
            const int aa = wave + 8 * ja;
            const int Tj = aa < 4 ? 0 : (aa < 7 ? 1 : (aa < 9 ? 2 : 3)), Ti = aa - (Tj == 0 ? 0 : (Tj == 1 ? 3 : (Tj == 2 ? 5 : 6)));
            f32x4 acc = {0.f, 0.f, 0.f, 0.f}, accl = {0.f, 0.f, 0.f, 0.f};
            bf16x8 fav[4], fbv[4], fal[4], fbl[4];
#pragma unroll
            for (int ks = 0; ks < 4; ++ks) {
                fav[ks] = *(const bf16x8*)(KS + (16 * Tj + m) * 136 + 32 * ks + 8 * q); fbv[ks] = *(const bf16x8*)(QS + (16 * Ti + m) * 136 + 32 * ks + 8 * q);
                fal[ks] = *(const bf16x8*)(KL + (16 * Tj + m) * 136 + 32 * ks + 8 * q); fbl[ks] = *(const bf16x8*)(QL + (16 * Ti + m) * 136 + 32 * ks + 8 * q);
            }
            SCHED_FENCE();
#pragma unroll
            for (int ks = 0; ks < 4; ++ks) { accl = mfma16(fal[ks], fbv[ks], accl); acc = mfma16(fav[ks], fbv[ks], acc); accl = mfma16(fav[ks], fbl[ks], accl); }
            acc = acc + accl * (1.f / LO_SCALE);
            const int i = 16 * Ti + m; const float Gi = SG[i]; float v[4];
#pragma unroll
            for (int r = 0; r < 4; ++r) { const int j = 16 * Tj + 4 * q + r; v[r] = (i >= j) ? acc[r] * (128.f * __expf(Gi - SG[j])) : 0.f; }
            u32x2 w; w.x = pk2(v[0], v[1]); w.y = pk2(v[2], v[3]);
            *(u32x2*)(att + i * 64 + 16 * Tj + 4 * q) = w;
        }
        const int nk = wave < 2 ? 0 : (wave < 6 ? 2 : 1), k0 = wave < 6 ? 2 * (wave - 2) : 8 + (wave - 6);
        for (int jk = 0; jk < nk; ++jk) {
            const int kk = k0 + jk;
            const int Ti = kk < 1 ? 0 : (kk < 3 ? 1 : (kk < 6 ? 2 : 3)), Tj = kk - (Ti == 0 ? 0 : (Ti == 1 ? 1 : (Ti == 2 ? 3 : 6)));
            f32x4 acc = {0.f, 0.f, 0.f, 0.f};
            bf16x8 fa[4], fb[4];
#pragma unroll
            for (int ks = 0; ks < 4; ++ks) { fa[ks] = *(const bf16x8*)(KS + (16 * Ti + m) * 136 + 32 * ks + 8 * q); fb[ks] = *(const bf16x8*)(KS + (16 * Tj + m) * 136 + 32 * ks + 8 * q); }
            SCHED_FENCE();
#pragma unroll
            for (int ks = 0; ks < 4; ++ks) acc = mfma16(fa[ks], fb[ks], acc);
            const int j = 16 * Tj + m; const float Gj = SG[j];
#pragma unroll
            for (int r = 0; r < 4; ++r) { const int i = 16 * Ti + 4 * q + r; AF[i * 68 + j] = (i > j) ? SG[64 + i] * acc[r] * __expf(SG[i] - Gj) : 0.f; }
        }
        if (wave >= 6) {
            for (int jz = 0; jz < 3; ++jz) {
                const int z = 3 * (wave - 6) + jz;
                const int Tj = z < 1 ? 1 : (z < 3 ? 2 : 3), Ti = z - (Tj == 1 ? 0 : (Tj == 2 ? 1 : 3));
                *(u32x2*)(att + (16 * Ti + m) * 64 + 16 * Tj + 4 * q) = (u32x2){0u, 0u};
            }
        }
    }
    lds_barrier();
    {
        bf16_t* kdt = (bf16_t*)(ws + WS_KDT) + (size_t)task * 8192;
        for (int idx = tid; idx < 1024; idx += 512) { const int row = idx >> 3, ch = idx & 7; *(u32x4*)(kdt + row * 64 + 8 * ch) = *(const u32x4*)(KD + row * 72 + 8 * (ch ^ ((row >> 3) & 7))); }
        if (tid == 0) ((float*)(ws + WS_EGL))[task] = expf(SG[63]);
        int vz; asm volatile("v_mov_b32 %0, 0" : "=v"(vz));
        const float* AFv = AF + vz;
        float* TL = (float*)(lds + L_QS);
        float* OFF = (float*)(lds + L_KS);
        float* DINV = (float*)(lds + L_KS + 4096);
        if (wave == 0) {
            const int I = lane >> 4, c = lane & 15;
            const float* Ad = AF + (16 * I) * 68 + 16 * I;
            float d[16];
#pragma unroll
            for (int r = 0; r < 16; ++r) {
                float acc = (r == c) ? 1.f : 0.f;
#pragma unroll
                for (int r4 = 0; r4 < (r + 3) / 4; ++r4) {
                    const f32x4 av = *(const f32x4*)(Ad + r * 68 + 4 * r4);
                    if (4 * r4 + 0 < r) acc -= av[0] * d[4 * r4 + 0];
                    if (4 * r4 + 1 < r) acc -= av[1] * d[4 * r4 + 1];
                    if (4 * r4 + 2 < r) acc -= av[2] * d[4 * r4 + 2];
                    if (4 * r4 + 3 < r) acc -= av[3] * d[4 * r4 + 3];
                }
                d[r] = acc;
                DINV[(I * 16 + r) * 16 + c] = acc;
            }
        }
        lds_barrier();
#pragma unroll 1
        for (int I = 0; I < 4; ++I) {
            {
                const int r0 = 16 * I + 2 * wave;
                float s0 = (r0 == lane) ? 1.f : 0.f, s1 = (r0 + 1 == lane) ? 1.f : 0.f;
#pragma unroll 4
                for (int j = 0; j < 16 * I; j += 4) {
                    const float t0 = TL[(j + 0) * 64 + lane], t1 = TL[(j + 1) * 64 + lane], t2 = TL[(j + 2) * 64 + lane], t3 = TL[(j + 3) * 64 + lane];
                    const f32x4 a0 = *(const f32x4*)(AFv + r0 * 68 + j), a1 = *(const f32x4*)(AFv + (r0 + 1) * 68 + j);
                    s0 -= (a0[0] * t0 + a0[1] * t1) + (a0[2] * t2 + a0[3] * t3);
                    s1 -= (a1[0] * t0 + a1[1] * t1) + (a1[2] * t2 + a1[3] * t3);
                }
                OFF[(2 * wave) * 64 + lane] = s0; OFF[(2 * wave + 1) * 64 + lane] = s1;
            }
            lds_barrier();
            {
                const float* Dv = DINV + vz + (I * 16 + 2 * wave) * 16;
                float x[16];
#pragma unroll
                for (int r2 = 0; r2 < 16; ++r2) x[r2] = OFF[r2 * 64 + lane];
                float ta = 0.f, tb = 0.f;
#pragma unroll
                for (int r4 = 0; r4 < 4; ++r4) {
                    const f32x4 da = *(const f32x4*)(Dv + 4 * r4), db = *(const f32x4*)(Dv + 16 + 4 * r4);
                    ta += (da[0] * x[4 * r4] + da[1] * x[4 * r4 + 1]) + (da[2] * x[4 * r4 + 2] + da[3] * x[4 * r4 + 3]);
                    tb += (db[0] * x[4 * r4] + db[1] * x[4 * r4 + 1]) + (db[2] * x[4 * r4 + 2] + db[3] * x[4 * r4 + 3]);
                }
                const int ra = 16 * I + 2 * wave;
                TL[ra * 64 + lane] = ta; TL[(ra + 1) * 64 + lane] = tb;
                TB[ra * 72 + lane] = (bf16_t)f2bf(ta); TB[(ra + 1) * 72 + lane] = (bf16_t)f2bf(tb);
            }
            lds_barrier();
        }
    }
    {
        bf16_t* ut = (bf16_t*)(ws + WS_UT) + (size_t)task * 8192;
        {
            const int swb = (2 * wave + (m >> 3)) & 7;
            bf16x8 bv[2], fa[8];
#pragma unroll
            for (int s = 0; s < 2; ++s) bv[s] = *(const bf16x8*)(RT + (16 * wave + m) * 72 + 8 * ((4 * s + q) ^ swb));
#pragma unroll
            for (int i = 0; i < 8; ++i) { const int P = i >> 2, s = (i >> 1) & 1, t = i & 1; fa[i] = *(const bf16x8*)(TB + (32 * P + il(t, m)) * 72 + 32 * s + 8 * q); }
            SCHED_FENCE();
#pragma unroll
            for (int P = 0; P < 2; ++P) {
                f32x4 c0 = {0.f, 0.f, 0.f, 0.f}, c1 = {0.f, 0.f, 0.f, 0.f};
#pragma unroll
                for (int s = 0; s < 2; ++s) { c0 = mfma16(fa[4 * P + 2 * s], bv[s], c0); c1 = mfma16(fa[4 * P + 2 * s + 1], bv[s], c1); }
                *(bf16x8*)(ut + (16 * wave + m) * 64 + 32 * P + 8 * q) = pack8(c0, c1);
            }
        }
        bf16_t* nw = (bf16_t*)(ws + WS_NEGW) + (size_t)task * 8192;
        {
            const int Pd = wave >> 1, swa = (4 * Pd + (m >> 2)) & 7;
            bf16x8 fb[4], fa[4];
#pragma unroll
            for (int i = 0; i < 4; ++i) { const int tt = i >> 1, s = i & 1; fb[i] = *(const bf16x8*)(TB + (16 * (2 * (wave & 1) + tt) + m) * 72 + 32 * s + 8 * q); }
#pragma unroll
            for (int i = 0; i < 4; ++i) { const int s = i >> 1, t = i & 1; fa[i] = *(const bf16x8*)(RT + (128 + 32 * Pd + il(t, m)) * 72 + 8 * ((4 * s + q) ^ swa)); }
            SCHED_FENCE();
#pragma unroll
            for (int tt = 0; tt < 2; ++tt) {
                const int Ti = 2 * (wave & 1) + tt;
                f32x4 c0 = {0.f, 0.f, 0.f, 0.f}, c1 = {0.f, 0.f, 0.f, 0.f};
#pragma unroll
                for (int s = 0; s < 2; ++s) { c0 = mfma16(fa[2 * s], fb[2 * tt + s], c0); c1 = mfma16(fa[2 * s + 1], fb[2 * tt + s], c1); }
                *(bf16x8*)(nw + (16 * Ti + m) * 128 + 32 * Pd + 8 * q) = pack8(-c0, -c1);
            }
        }
    }
    lds_barrier();
}

constexpr int G_QS = 0, G_KS = 9216, G_KDT = 18432, G_VT = 27648, G_TOT = 46080, G_GR = 48128, G_W2 = 52224;
__device__ __forceinline__ void gla_prep(const Args& a, int l, int task, unsigned char* lds) {
    const int tid = otid(), lane = tid & 63, wave = __builtin_amdgcn_readfirstlane(tid >> 6), m = lane & 15, q = lane >> 4;
    const int bh = task >> 5, n = task & 31, b = bh >> 2, h = bh & 3;
    unsigned char* ws = a.ws;
    bf16_t* QS = (bf16_t*)(lds + G_QS); bf16_t* KS = (bf16_t*)(lds + G_KS); bf16_t* KDT = (bf16_t*)(lds + G_KDT); bf16_t* VT = (bf16_t*)(lds + G_VT);
    float* TOT = (float*)(lds + G_TOT);
    const size_t tok0 = (size_t)b * SEQ + 64 * n;
    const int d = lane, tg = wave;
    float* GR = (float*)(lds + G_GR);
    f32x4 grv;
    if (tid < 256) grv = *(const f32x4*)((const float*)(ws + WS_SMALL) + (tok0 + (tid >> 2)) * 32 + 8 + 4 * (tid & 3));
    float c[8];
    bf16_t qraw[8], kraw[8];
    {
        const bf16_t* qp = (const bf16_t*)(ws + WS_GQ) + (tok0 + 8 * tg) * 256 + 64 * h + d;
        const bf16_t* kp = (const bf16_t*)(ws + WS_GK) + (tok0 + 8 * tg) * 256 + 64 * h + d;
#pragma unroll
        for (int tt = 0; tt < 8; ++tt) { qraw[tt] = qp[tt * 256]; kraw[tt] = kp[tt * 256]; }
    }
    const int vt = tid >> 3, vc2 = tid & 7;
    const bf16_t* vp = (const bf16_t*)(ws + WS_GV) + (tok0 + vt) * 512 + 128 * h + 16 * vc2;
    const u32x4 vw0 = *(const u32x4*)vp, vw1 = *(const u32x4*)(vp + 8);
    if (tid < 256) *(f32x4*)(GR + (tid >> 2) * 16 + 4 * (tid & 3)) = grv;
    lds_barrier();
    {
        float w2[16];
        const float* W2L = (const float*)(lds + G_W2);
#pragma unroll
        for (int r = 0; r < 16; ++r) w2[r] = W2L[r * 64 + d];
        const float bias = W2L[1024 + d];
        float run = 0.f;
#pragma unroll
        for (int tt = 0; tt < 8; ++tt) {
            const float* gr = GR + (8 * tg + tt) * 16;
            float lg = bias;
#pragma unroll
            for (int r4 = 0; r4 < 4; ++r4) { const f32x4 gv = *(const f32x4*)(gr + 4 * r4); lg += gv[0] * w2[4 * r4] + gv[1] * w2[4 * r4 + 1] + gv[2] * w2[4 * r4 + 2] + gv[3] * w2[4 * r4 + 3]; }
            const float lf = (fminf(lg, 0.f) - __logf(1.f + __expf(-fabsf(lg)))) * 0.0625f;
            run += lf; c[tt] = run;
        }
        TOT[tg * 64 + d] = run;
    }
    {
        const int t = vt, c2 = vc2;
        const unsigned ww[8] = {vw0.x, vw0.y, vw0.z, vw0.w, vw1.x, vw1.y, vw1.z, vw1.w};
#pragma unroll
        for (int e = 0; e < 8; ++e) { VT[(16 * c2 + 2 * e) * 72 + t] = (bf16_t)(ww[e] & 0xffffu); VT[(16 * c2 + 2 * e + 1) * 72 + t] = (bf16_t)(ww[e] >> 16); }
    }
    lds_barrier();
    {
        float pre = 0.f, Bl = 0.f;
#pragma unroll
        for (int g = 0; g < 8; ++g) { const float tv = TOT[g * 64 + d]; if (g < tg) pre += tv; Bl += tv; }
        bf16_t* qt = (bf16_t*)(ws + WS_GQT) + (size_t)task * 4096;
        float kd[8];
#pragma unroll
        for (int tt = 0; tt < 8; ++tt) {
            const float Bv = c[tt] + pre; const int t = 8 * tg + tt;
            const float Rh = 0.5f * Bl;
            const float qv = h1f(qraw[tt]) * 0.125f * __expf(fminf(fmaxf(Bv - Rh, -9.5f), 9.5f)), kv = h1f(kraw[tt]);
            const bf16_t qb = (bf16_t)f2bf(qv);
            QS[t * 72 + d] = qb; qt[t * 64 + d] = qb;
            KS[t * 72 + d] = (bf16_t)f2bf(kv * __expf(fmaxf(fminf(Rh - Bv, 9.5f), -9.5f)));
            kd[tt] = kv * __expf(Bl - Bv);
        }
        u32x4 w; w.x = pk2(kd[0], kd[1]); w.y = pk2(kd[2], kd[3]); w.z = pk2(kd[4], kd[5]); w.w = pk2(kd[6], kd[7]);
        *(u32x4*)(KDT + d * 72 + 8 * tg) = w;
        if (tg == 0) ((float*)(ws + WS_EBL))[(size_t)task * 64 + d] = expf(Bl);
    }
    lds_barrier();
    {
        bf16_t* vt = (bf16_t*)(ws + WS_GVT) + (size_t)task * 8192;
        for (int idx = tid; idx < 1024; idx += 512) { const int row = idx >> 3, ch = idx & 7; *(u32x4*)(vt + row * 64 + 8 * ch) = *(const u32x4*)(VT + row * 72 + 8 * ch); }
    }
    {
        bf16_t* att = (bf16_t*)(ws + WS_GATT) + (size_t)task * 4096;
#pragma unroll
        for (int tt = 0; tt < 2; ++tt) {
            const int tile = 2 * wave + tt, Tj = tile >> 2, Ti = tile & 3;
            f32x4 acc = {0.f, 0.f, 0.f, 0.f};
            if (Ti >= Tj) {
#pragma unroll
                for (int ks = 0; ks < 2; ++ks) {
                    const bf16x8 av = *(const bf16x8*)(KS + (16 * Tj + m) * 72 + 32 * ks + 8 * q), bv = *(const bf16x8*)(QS + (16 * Ti + m) * 72 + 32 * ks + 8 * q);
                    acc = mfma16(av, bv, acc);
                }
            }
            const int i = 16 * Ti + m; float v[4];
#pragma unroll
            for (int r = 0; r < 4; ++r) { const int j = 16 * Tj + 4 * q + r; v[r] = (i >= j) ? acc[r] : 0.f; }
            u32x2 w; w.x = pk2(v[0], v[1]); w.y = pk2(v[2], v[3]);
            *(u32x2*)(att + i * 64 + 16 * Tj + 4 * q) = w;
        }
    }
    {
        bf16_t* st = (bf16_t*)(ws + WS_GST) + (size_t)task * 8192;
#pragma unroll
        for (int Tk = 0; Tk < 4; ++Tk) {
            f32x4 acc = {0.f, 0.f, 0.f, 0.f};
#pragma unroll
            for (int s = 0; s < 2; ++s) {
                const bf16x8 av = *(const bf16x8*)(KDT + (16 * Tk + m) * 72 + 32 * s + 8 * q), bv = *(const bf16x8*)(VT + (16 * wave + m) * 72 + 32 * s + 8 * q);
                acc = mfma16(av, bv, acc);
            }
            u32x2 w; w.x = pk2(acc[0], acc[1]); w.y = pk2(acc[2], acc[3]);
            *(u32x2*)(st + (16 * wave + m) * 64 + 16 * Tk + 4 * q) = w;
        }
    }
    lds_barrier();
}

constexpr int SC_NW = 0, SC_KD = 17408, SC_BUF = 35840;
struct ScanSet { u32x4 pw[2], pk[2], pu[2]; };
__device__ __forceinline__ void scan_load(unsigned char* ws, size_t task, int tid, int w, int m, int q, ScanSet& s) {
    const bf16_t* negW = (const bf16_t*)(ws + WS_NEGW) + task * 8192; const bf16_t* kdT = (const bf16_t*)(ws + WS_KDT) + task * 8192; const bf16_t* uT = (const bf16_t*)(ws + WS_UT) + task * 8192;
#pragma unroll
    for (int i = 0; i < 2; ++i) { const int idx = tid + 512 * i; s.pw[i] = *(const u32x4*)(negW + idx * 8); s.pk[i] = *(const u32x4*)(kdT + idx * 8); s.pu[i] = *(const u32x4*)(uT + (16 * w + m) * 64 + 32 * i + 8 * q); }
}
__device__ __forceinline__ void scan_stage(unsigned char* buf, int tid, const ScanSet& s) {
#pragma unroll
    for (int i = 0; i < 2; ++i) { const int idx = tid + 512 * i;
        *(u32x4*)(buf + SC_NW + ((idx >> 4) * 136 + (((idx & 15) ^ (((idx >> 8) & 1) << 2)) * 8)) * 2) = s.pw[i];
        *(u32x4*)(buf + SC_KD + ((idx >> 3) * 72 + (((idx & 7) ^ (((idx >> 7) & 1) << 2)) * 8)) * 2) = s.pk[i]; }
}
__device__ __forceinline__ void dn_scan(const Args& a, int bh, int half, unsigned char* lds) {
    const int tid = otid(), lane = tid & 63, wv = __builtin_amdgcn_readfirstlane(tid >> 6), w = 4 * half + (wv & 3), m = lane & 15, q = lane >> 4;
    const bool active = wv < 4;
    unsigned char* ws = a.ws;
    f32x4 S[8];
#pragma unroll
    for (int i = 0; i < 8; ++i) S[i] = (f32x4){0.f, 0.f, 0.f, 0.f};
    const float eglv = ((const float*)(ws + WS_EGL))[(size_t)bh * 32 + (lane & 31)];
    ScanSet A, B; u32x4 cu0, cu1;
    { ScanSet t0; scan_load(ws, (size_t)bh * 32, tid, w, m, q, t0); scan_load(ws, (size_t)bh * 32 + 1, tid, w, m, q, B); scan_stage(lds, tid, t0); cu0 = t0.pu[0]; cu1 = t0.pu[1]; }
    __syncthreads();
#define SCAN_STEP(n, ISSUE, STAGE) do { \
        const size_t task = (size_t)bh * 32 + (n); \
        unsigned char* buf = lds + ((n) & 1) * SC_BUF; \
        const bf16_t* NW = (const bf16_t*)(buf + SC_NW); const bf16_t* KD = (const bf16_t*)(buf + SC_KD); \
        bf16_t* uT = (bf16_t*)(ws + WS_UT) + task * 8192; bf16_t* ST = (bf16_t*)(ws + WS_DNST) + task * 16384; \
        const float egl = __shfl(eglv, (n)); \
        if ((n) + 2 < 32) scan_load(ws, task + 2, tid, w, m, q, ISSUE); \
        if (active) { \
        bf16x8 Sb[4], Vb[2]; \
        _Pragma("unroll") for (int ks = 0; ks < 4; ++ks) { Sb[ks] = pack8(S[2 * ks], S[2 * ks + 1]); *(bf16x8*)(ST + (16 * w + m) * 128 + 32 * ks + 8 * q) = Sb[ks]; } \
        bf16x8 fa[8], fb[8]; \
        _Pragma("unroll") for (int i = 0; i < 8; ++i) { const int ks = i >> 1, t = i & 1; fa[i] = *(const bf16x8*)(NW + il(t, m) * 136 + ((4 * ks + q) ^ ((m >> 3) << 2)) * 8); } \
        SCHED_FENCE(); \
        f32x4 v0 = {bflo(cu0.x), bfhi(cu0.x), bflo(cu0.y), bfhi(cu0.y)}, v1 = {bflo(cu0.z), bfhi(cu0.z), bflo(cu0.w), bfhi(cu0.w)}; \
        _Pragma("unroll") for (int ks = 0; ks < 4; ++ks) { v0 = mfma16(fa[2 * ks], Sb[ks], v0); v1 = mfma16(fa[2 * ks + 1], Sb[ks], v1); } \
        _Pragma("unroll") for (int i = 0; i < 8; ++i) { const int ks = i >> 1, t = i & 1; fb[i] = *(const bf16x8*)(NW + (32 + il(t, m)) * 136 + ((4 * ks + q) ^ ((m >> 3) << 2)) * 8); } \
        SCHED_FENCE(); \
        Vb[0] = pack8(v0, v1); \
        *(bf16x8*)(uT + (16 * w + m) * 64 + 8 * q) = Vb[0]; \
        v0 = (f32x4){bflo(cu1.x), bfhi(cu1.x), bflo(cu1.y), bfhi(cu1.y)}; v1 = (f32x4){bflo(cu1.z), bfhi(cu1.z), bflo(cu1.w), bfhi(cu1.w)}; \
        _Pragma("unroll") for (int ks = 0; ks < 4; ++ks) { v0 = mfma16(fb[2 * ks], Sb[ks], v0); v1 = mfma16(fb[2 * ks + 1], Sb[ks], v1); } \
        _Pragma("unroll") for (int i = 0; i < 8; ++i) { const int Pd = i >> 2, t = (i >> 1) & 1, s = i & 1; fa[i] = *(const bf16x8*)(KD + (32 * Pd + il(t, m)) * 72 + ((4 * s + q) ^ ((m >> 3) << 2)) * 8); } \
        SCHED_FENCE(); \
        Vb[1] = pack8(v0, v1); \
        *(bf16x8*)(uT + (16 * w + m) * 64 + 32 + 8 * q) = Vb[1]; \
        _Pragma("unroll") for (int i = 0; i < 8; i += 2) { const int Pd = i >> 2, t = (i >> 1) & 1; \
            f32x4 acc = S[2 * Pd + t] * egl; acc = mfma16(fa[i], Vb[0], acc); acc = mfma16(fa[i + 1], Vb[1], acc); S[2 * Pd + t] = acc; } \
        _Pragma("unroll") for (int i = 0; i < 8; ++i) { const int Pd = 2 + (i >> 2), t = (i >> 1) & 1, s = i & 1; fb[i] = *(const bf16x8*)(KD + (32 * Pd + il(t, m)) * 72 + ((4 * s + q) ^ ((m >> 3) << 2)) * 8); } \
        SCHED_FENCE(); \
        _Pragma("unroll") for (int i = 0; i < 8; i += 2) { const int Pd = 2 + (i >> 2), t = (i >> 1) & 1; \
            f32x4 acc = S[2 * Pd + t] * egl; acc = mfma16(fb[i], Vb[0], acc); acc = mfma16(fb[i + 1], Vb[1], acc); S[2 * Pd + t] = acc; } \
        SCHED_FENCE(); } \
        if ((n) + 1 < 32) { scan_stage(lds + (((n) + 1) & 1) * SC_BUF, tid, STAGE); cu0 = STAGE.pu[0]; cu1 = STAGE.pu[1]; } \
        lds_barrier(); } while (0)
#pragma unroll 1
    for (int n = 0; n < 32; n += 2) { SCAN_STEP(n, A, B); SCAN_STEP(n + 1, B, A); }
#undef SCAN_STEP
}
__device__ __forceinline__ void gla_prefix(const Args& a, int vb, int nvb) {
    unsigned char* ws = a.ws;
    for (int item = vb * 512 + otid(); item < 32768; item += nvb * 512) {
        const int bh = item >> 10, dv = (item >> 3) & 127, kg = item & 7;
        float S[8];
#pragma unroll
        for (int e = 0; e < 8; ++e) S[e] = 0.f;
        for (int n0 = 0; n0 < 32; n0 += 8) {
            u32x4 dw[8]; f32x4 e0[8], e1[8];
#pragma unroll
            for (int j = 0; j < 8; ++j) {
                const size_t task = (size_t)bh * 32 + n0 + j;
                dw[j] = *(const u32x4*)((const bf16_t*)(ws + WS_GST) + task * 8192 + dv * 64 + 8 * kg);
                const float* eb = (const float*)(ws + WS_EBL) + task * 64 + 8 * kg;
                e0[j] = *(const f32x4*)eb; e1[j] = *(const f32x4*)(eb + 4);
            }
#pragma unroll
            for (int j = 0; j < 8; ++j) {
                const size_t task = (size_t)bh * 32 + n0 + j;
                const f32x4 r0 = {sqrtf(e0[j][0]), sqrtf(e0[j][1]), sqrtf(e0[j][2]), sqrtf(e0[j][3])}, r1 = {sqrtf(e1[j][0]), sqrtf(e1[j][1]), sqrtf(e1[j][2]), sqrtf(e1[j][3])};
                u32x4 o; o.x = pk2(S[0] * r0[0], S[1] * r0[1]); o.y = pk2(S[2] * r0[2], S[3] * r0[3]); o.z = pk2(S[4] * r1[0], S[5] * r1[1]); o.w = pk2(S[6] * r1[2], S[7] * r1[3]);
                *(u32x4*)((bf16_t*)(ws + WS_GST) + task * 8192 + dv * 64 + 8 * kg) = o;
                float dS[8]; unpack8(dw[j], dS);
                S[0] = S[0] * e0[j][0] + dS[0]; S[1] = S[1] * e0[j][1] + dS[1]; S[2] = S[2] * e0[j][2] + dS[2]; S[3] = S[3] * e0[j][3] + dS[3];
                S[4] = S[4] * e1[j][0] + dS[4]; S[5] = S[5] * e1[j][1] + dS[5]; S[6] = S[6] * e1[j][2] + dS[6]; S[7] = S[7] * e1[j][3] + dS[7];
            }
        }
    }
}

template <int DK>
__device__ __forceinline__ void out_phase(const Args& a, int l, bool gla, int first, int stride, unsigned char* lds) {
    const int tid = otid(), lane = tid & 63, w = __builtin_amdgcn_readfirstlane(tid >> 6), m = lane & 15, q = lane >> 4;
    unsigned char* ws = a.ws;
    constexpr int QP = DK + 8, NQ = 64 * DK / 8 / 512;
    constexpr int B_AT = 64 * QP * 2, B_SZ = B_AT + 64 * 72 * 2, O_RED = 2 * B_SZ;
    const float oscale = gla ? 1.f : (1.f / 128.f);
    const bf16_t* STb = (const bf16_t*)(ws + (gla ? WS_GST : WS_DNST)); const bf16_t* QTb = (const bf16_t*)(ws + (gla ? WS_GQT : WS_DQT));
    const bf16_t* VTb = (const bf16_t*)(ws + (gla ? WS_GVT : WS_UT)); const bf16_t* ATb = (const bf16_t*)(ws + (gla ? WS_GATT : WS_DATT));
    const bf16_t* Z = (const bf16_t*)(ws + (gla ? WS_GZ : WS_DNZ));
    bf16_t* O = (bf16_t*)(ws + WS_O);
    const f32x4 gv = *(const f32x4*)((gla ? a.gla_g : a.dn_g) + l * 128 + 16 * w + 4 * q);
    u32x4 pq[NQ], pa, pS[DK / 32], pV[2]; u32x2 pz[4];
    if (first >= NTASK) return;
#define OUT_LOAD(task) do { const size_t _t = (size_t)(task); const int _bh = (task) >> 5, _n = (task) & 31; const size_t _tok0 = (size_t)(_bh >> 2) * SEQ + 64 * _n; \
        _Pragma("unroll") for (int i = 0; i < NQ; ++i) pq[i] = *(const u32x4*)(QTb + _t * (64 * DK) + (tid + 512 * i) * 8); \
        pa = *(const u32x4*)(ATb + _t * 4096 + tid * 8); \
        _Pragma("unroll") for (int ks = 0; ks < DK / 32; ++ks) pS[ks] = *(const u32x4*)(STb + _t * (128 * DK) + (16 * w + m) * DK + 32 * ks + 8 * q); \
        _Pragma("unroll") for (int s = 0; s < 2; ++s) pV[s] = *(const u32x4*)(VTb + _t * 8192 + (16 * w + m) * 64 + 32 * s + 8 * q); \
        _Pragma("unroll") for (int Ti = 0; Ti < 4; ++Ti) pz[Ti] = *(const u32x2*)(Z + (_tok0 + 16 * Ti + m) * 512 + 128 * (_bh & 3) + 16 * w + 4 * q); } while (0)
#define OUT_STAGE(buf) do { unsigned char* _b = lds + (buf) * B_SZ; \
        _Pragma("unroll") for (int i = 0; i < NQ; ++i) { const int idx = tid + 512 * i; *(u32x4*)(_b + ((idx / (DK / 8)) * QP + (idx % (DK / 8)) * 8) * 2) = pq[i]; } \
        *(u32x4*)(_b + B_AT + ((tid >> 3) * 72 + (tid & 7) * 8) * 2) = pa; } while (0)
    OUT_LOAD(first);
    OUT_STAGE(0);
    __syncthreads();
    int it = 0;
    for (int task = first; task < NTASK; task += stride, ++it) {
        const int bh = task >> 5, n = task & 31, h = bh & 3;
        const size_t tok0 = (size_t)(bh >> 2) * SEQ + 64 * n;
        u32x4 cS[DK / 32], cV[2]; u32x2 cz[4];
#pragma unroll
        for (int ks = 0; ks < DK / 32; ++ks) cS[ks] = pS[ks];
        cV[0] = pV[0]; cV[1] = pV[1];
#pragma unroll
        for (int Ti = 0; Ti < 4; ++Ti) cz[Ti] = pz[Ti];
        const bool more = task + stride < NTASK;
        if (more) OUT_LOAD(task + stride);
        const bf16_t* QS = (const bf16_t*)(lds + (it & 1) * B_SZ); const bf16_t* AS = (const bf16_t*)(lds + (it & 1) * B_SZ + B_AT);
        float* red = (float*)(lds + O_RED) + (it & 1) * 512;
        f32x4 acc[4];
#pragma unroll
        for (int Ti = 0; Ti < 4; ++Ti) acc[Ti] = (f32x4){0.f, 0.f, 0.f, 0.f};
#pragma unroll
        for (int ks = 0; ks < DK / 32; ks += 2) {
            bf16x8 fb[8];
#pragma unroll
            for (int i = 0; i < 8; ++i) fb[i] = *(const bf16x8*)(QS + (16 * (i & 3) + m) * QP + 32 * (ks + (i >> 2)) + 8 * q);
            SCHED_FENCE();
#pragma unroll
            for (int i = 0; i < 8; ++i) acc[i & 3] = mfma16(__builtin_bit_cast(bf16x8, cS[ks + (i >> 2)]), fb[i], acc[i & 3]);
            SCHED_FENCE();
        }
        {
            bf16x8 fb[8];
#pragma unroll
            for (int i = 0; i < 8; ++i) fb[i] = *(const bf16x8*)(AS + (16 * (i & 3) + m) * 72 + 32 * (i >> 2) + 8 * q);
            SCHED_FENCE();
#pragma unroll
            for (int i = 0; i < 8; ++i) acc[i & 3] = mfma16(__builtin_bit_cast(bf16x8, cV[i >> 2]), fb[i], acc[i & 3]);
            SCHED_FENCE();
        }
#pragma unroll
        for (int Ti = 0; Ti < 4; ++Ti) {
            acc[Ti] = acc[Ti] * oscale;
            float ss = acc[Ti][0] * acc[Ti][0] + acc[Ti][1] * acc[Ti][1] + acc[Ti][2] * acc[Ti][2] + acc[Ti][3] * acc[Ti][3];
            ss += __shfl_xor(ss, 16); ss += __shfl_xor(ss, 32);
            if (q == 0) red[w * 64 + 16 * Ti + m] = ss;
        }
        if (more) OUT_STAGE((it + 1) & 1);
        lds_barrier();
#pragma unroll
        for (int Ti = 0; Ti < 4; ++Ti) {
            const int t = 16 * Ti + m;
            float tot = 0.f;
#pragma unroll
            for (int ww = 0; ww < 8; ++ww) tot += red[ww * 64 + t];
            const float rstd = rsqrtf(tot * (1.f / 128.f) + EPS);
            const float z0 = hlo(cz[Ti].x), z1 = hhi(cz[Ti].x), z2 = hlo(cz[Ti].y), z3 = hhi(cz[Ti].y);
            u32x2 o; o.x = pkh2(acc[Ti][0] * rstd * gv[0] * siluf(z0), acc[Ti][1] * rstd * gv[1] * siluf(z1));
            o.y = pkh2(acc[Ti][2] * rstd * gv[2] * siluf(z2), acc[Ti][3] * rstd * gv[3] * siluf(z3));
            *(u32x2*)(O + (tok0 + t) * 1024 + (gla ? 512 : 0) + 128 * h + 16 * w + 4 * q) = o;
        }
    }
    __syncthreads();
#undef OUT_LOAD
#undef OUT_STAGE
}

constexpr int LDS_BYTES = 152064 + 6144 + 16;
__global__ void __launch_bounds__(512, 2) mk_fwd(Args a) {
    extern __shared__ __attribute__((aligned(16))) unsigned char lds[];
    cg::grid_group grid = cg::this_grid();
    const int G = gridDim.x, bid = blockIdx.x;
    int ph = 0;
#define PHASE_BEGIN if (ph >= a.ph_lo && ph < a.ph_hi) {
#define PHASE_END   if (ph + 1 < a.ph_hi) { \
        xcd_barrier(xbar); } \
    } ++ph;
    volatile LAS unsigned* bst = (volatile LAS unsigned*)((LAS unsigned char*)lds + LDS_BYTES - 16);
    if (threadIdx.x < 4) bst[threadIdx.x] = 0u;
    __syncthreads();
    const XcdBarrier xbar = xcd_barrier_post((unsigned*)(a.ws + WS_BAR), bst);
    if (a.ph_hi > 4096) grid.sync();
    PHASE_BEGIN prologue(a, lds); PHASE_END
    for (int l = 0; l < 2; ++l) {
        const float* resid = l == 0 ? a.x : a.out;
        PHASE_BEGIN {
            pg8::Gemm g{(const bf16_t*)(a.ws + WS_XB), (const bf16_t*)(a.ws + WS_WIN + l * WIN_BYTES), MROWS, NPROJ, DM};
            pg8::StaticOrder S; S.init(MROWS, NPROJ, G, bid); EpiProj E{a.ws};
            pg8::gemm_phase<EpiProj>((LAS unsigned char*)lds, g, S, E);
        } PHASE_END
        PHASE_BEGIN
            { DnPre P; if (bid < NTASK) dn_preload(a, bid, otid(), P);
              int hs = -1; float dtb = 0.f, nexpa = 0.f;
              for (int t = bid; t < NTASK; t += G) {
                  const int h = (t >> 5) & 3;
                  if (h != hs) {
                      const int tt = otid();
                      if (tt < 384) { const int X = tt >> 7, r = tt & 127, tap = r >> 5, c4 = r & 31;
                          const float sc = X < 2 ? (1.f / 4096.f) : 1.f;
                          *(f32x4*)((float*)(lds + L_CW) + X * 512 + tap * 128 + 4 * c4) = *(const f32x4*)(a.conv_w + (size_t)l * 4 * 1536 + tap * 1536 + X * 512 + 128 * h + 4 * c4) * sc; }
                      dtb = a.dt_bias[l * 4 + h]; nexpa = -__expf(a.a_log[l * 4 + h]);
                      hs = h; lds_barrier();
                  }
                  dn_prep(a, l, t, t + G < NTASK ? t + G : -1, P, dtb, nexpa, lds);
              } }
            { int hs = -1;
              for (int t = bid; t < NTASK; t += G) {
                  const int h = (t >> 5) & 3;
                  if (h != hs) {
                      const int tt = otid(); float* W2L = (float*)(lds + G_W2);
                      for (int i = tt; i < 1088; i += 512) W2L[i] = i < 1024 ? a.gw2[(size_t)l * 16 * 256 + (i >> 6) * 256 + 64 * h + (i & 63)] : a.gb[l * 256 + 64 * h + (i - 1024)];
                      hs = h; lds_barrier();
                  }
                  gla_prep(a, l, t, lds);
              } }
        PHASE_END
        PHASE_BEGIN
            if (bid < 64) dn_scan(a, (bid & 7) + 8 * (bid >> 4), (bid >> 3) & 1, lds);
            else {
                unsigned* cnt = (unsigned*)(a.ws + WS_CNT) + 64 * l;
                const int vb = bid - 64, nvb = G - 64, nprod = nvb < 64 ? nvb : 64;
                gla_prefix(a, vb, nvb);
                asm volatile("s_waitcnt vmcnt(0)" ::: "memory");
                __syncthreads();
                if (threadIdx.x == 0) {
                    if (vb < nprod) { __builtin_amdgcn_fence(__ATOMIC_RELEASE, "agent"); asm volatile("s_waitcnt vmcnt(0)" ::: "memory"); (void)xb_add(cnt, 1u); }
                    unsigned sp = 0;
                    while (xb_ld(cnt) < (unsigned)nprod) { __builtin_amdgcn_s_sleep(4); if (++sp > (1u << 24)) break; }
                    __builtin_amdgcn_fence(__ATOMIC_ACQUIRE, "agent"); asm volatile("s_waitcnt vmcnt(0)" ::: "memory");
                }
                __syncthreads();
                out_phase<64>(a, l, true, vb, nvb, lds);
                if (l == 0) { const int tt = otid(); convert_weights(a, 1, vb * 8 + (tt >> 6), nvb * 8, (float*)(lds + (tt >> 6) * 8448), tt & 63); }
            }
        PHASE_END
        PHASE_BEGIN
            out_phase<128>(a, l, false, bid, G, lds);
        PHASE_END
        PHASE_BEGIN {
            pg8::Gemm g{(const bf16_t*)(a.ws + WS_O), (const bf16_t*)(a.ws + WS_WOUT + l * WOUT_BYTES), MROWS, DM, DM};
            pg8::StaticOrder S; S.init(MROWS, DM, G, bid);
            EpiOutLN E{resid, a.out, l == 0 ? (bf16_t*)(a.ws + WS_XB) : nullptr, a.ln_g + l * DM, a.ln_b + l * DM, (unsigned*)(a.ws + WS_XBUF), (unsigned*)(a.ws + WS_LNCNT) + l * 4096};
            pg8::gemm_phase<EpiOutLN>((LAS unsigned char*)lds, g, S, E);
        } PHASE_END
    }
}
constexpr int NPHASE = 11;

extern "C" void kernel_launch(void* const* d_in, const int* in_sizes, int n_in, void* d_out, int out_size,
                              void* d_ws, size_t ws_size, hipStream_t stream) {
    static int grid = 0;
    if (grid == 0) {
        int dev = 0, cus = 0, per_cu = 0;
        (void)hipGetDevice(&dev);
        (void)hipDeviceGetAttribute(&cus, hipDeviceAttributeMultiprocessorCount, dev);
        (void)hipFuncSetAttribute((const void*)mk_fwd, hipFuncAttributeMaxDynamicSharedMemorySize, LDS_BYTES);
        (void)hipOccupancyMaxActiveBlocksPerMultiprocessor(&per_cu, (const void*)mk_fwd, 512, LDS_BYTES);
        if (per_cu < 1) { fprintf(stderr, "kernel_launch: occupancy query reports %d blocks per CU\n", per_cu); }
        grid = cus > 0 ? cus : 256;
        if (ws_size < WS_END) { fprintf(stderr, "kernel_launch: workspace too small: %zu < %zu\n", ws_size, (size_t)WS_END); grid = -1; }
    }
    if (grid < 0) return;
    Args a{};
    a.x = (const float*)d_in[0]; a.w_in = (const float*)d_in[1]; a.conv_w = (const float*)d_in[2]; a.a_log = (const float*)d_in[3];
    a.dt_bias = (const float*)d_in[4]; a.gw2 = (const float*)d_in[5]; a.gb = (const float*)d_in[6]; a.dn_g = (const float*)d_in[7];
    a.gla_g = (const float*)d_in[8]; a.w_out = (const float*)d_in[9]; a.ln_g = (const float*)d_in[10]; a.ln_b = (const float*)d_in[11];
    a.out = (float*)d_out; a.ws = (unsigned char*)d_ws;
#ifndef MK_LAUNCHES
#define MK_LAUNCHES 1
#endif
    (void)hipMemsetAsync((char*)d_ws + WS_BAR, 0, 65536, stream);
    for (int li = 0; li < MK_LAUNCHES; ++li) {
        a.ph_lo = MK_LAUNCHES == 1 ? 0 : li; a.ph_hi = MK_LAUNCHES == 1 ? NPHASE : li + 1;
        void* args[] = {&a};
        hipError_t e = hipLaunchCooperativeKernel((const void*)mk_fwd, dim3(grid), dim3(512), args, LDS_BYTES, stream);
        if (e != hipSuccess) { fprintf(stderr, "cooperative launch failed: %s\n", hipGetErrorString(e)); break; }
    }
}
```

```cpp
#include <hip/hip_runtime.h>
#include <hip/hip_cooperative_groups.h>
#include <cstdio>
namespace cg = cooperative_groups;

#define LAS __attribute__((address_space(3)))
typedef unsigned short bf16_t;
typedef short bf16x8 __attribute__((ext_vector_type(8)));
typedef float f32x4 __attribute__((ext_vector_type(4)));
typedef unsigned u32x4 __attribute__((ext_vector_type(4)));
typedef unsigned u32x2 __attribute__((ext_vector_type(2)));

constexpr int SEQ = 2048, DM = 1024, MROWS = 16384, NPROJ = 3840, NTASK = 1024;
constexpr float DEEP_ALPHA = 1.41421356237f, EPS = 1e-6f;
constexpr size_t MiB = 1u << 20;
constexpr size_t WS_EGL = 0, WS_EBL = 65536, WS_SMALL = 1 * MiB, WS_WIN = 3 * MiB, WS_WOUT = 18 * MiB, WS_XB = 22 * MiB;
constexpr size_t WS_NEGW = 22 * MiB, WS_KDT = 38 * MiB;
constexpr size_t WS_DNZ = 54 * MiB, WS_GZ = 70 * MiB;
constexpr size_t WS_DNQ = 86 * MiB, WS_DNK = 102 * MiB, WS_DNV = 118 * MiB, WS_GQ = 134 * MiB, WS_GK = 142 * MiB, WS_GV = 150 * MiB;
constexpr size_t WS_DNST = 86 * MiB;
constexpr size_t WS_UT = 166 * MiB, WS_DQT = 182 * MiB, WS_DATT = 198 * MiB, WS_GQT = 206 * MiB, WS_GATT = 214 * MiB, WS_GVT = 222 * MiB, WS_GST = 238 * MiB;
constexpr size_t WS_Y = 166 * MiB, WS_END = 255 * MiB;
constexpr size_t WS_O = 118 * MiB;
constexpr size_t WS_CNT = 540672, WS_LNCNT = 544768, WS_XBUF = 254 * MiB;
constexpr size_t WIN_BYTES = (size_t)NPROJ * DM * 2, WOUT_BYTES = (size_t)DM * DM * 2;

typedef _Float16 h16x2 __attribute__((ext_vector_type(2)));
typedef _Float16 h16x8 __attribute__((ext_vector_type(8)));
__device__ __forceinline__ unsigned f2bf(float f) { return (unsigned)__builtin_bit_cast(unsigned short, (_Float16)f); }
__device__ __forceinline__ unsigned pk2(float lo, float hi) { h16x2 v = {(_Float16)lo, (_Float16)hi}; return __builtin_bit_cast(unsigned, v); }
__device__ __forceinline__ unsigned pkh2(float lo, float hi) { return pk2(lo, hi); }
__device__ __forceinline__ float bflo(unsigned w) { return (float)__builtin_bit_cast(h16x2, w).x; }
__device__ __forceinline__ float bfhi(unsigned w) { return (float)__builtin_bit_cast(h16x2, w).y; }
__device__ __forceinline__ float hlo(unsigned w) { return bflo(w); }
__device__ __forceinline__ float hhi(unsigned w) { return bfhi(w); }
__device__ __forceinline__ float h1f(bf16_t h) { return (float)__builtin_bit_cast(_Float16, h); }
__device__ __forceinline__ float bf1(bf16_t h) { return h1f(h); }
__device__ __forceinline__ bf16x8 pack8(f32x4 a, f32x4 b) { u32x4 w; w.x = pk2(a[0], a[1]); w.y = pk2(a[2], a[3]); w.z = pk2(b[0], b[1]); w.w = pk2(b[2], b[3]); return __builtin_bit_cast(bf16x8, w); }
__device__ __forceinline__ void unpack8(u32x4 w, float* o) { o[0] = bflo(w.x); o[1] = bfhi(w.x); o[2] = bflo(w.y); o[3] = bfhi(w.y); o[4] = bflo(w.z); o[5] = bfhi(w.z); o[6] = bflo(w.w); o[7] = bfhi(w.w); }
__device__ __forceinline__ void unpackh8(u32x4 w, float* o) { unpack8(w, o); }
__device__ __forceinline__ f32x4 mfma16(bf16x8 a, bf16x8 b, f32x4 c) { return __builtin_amdgcn_mfma_f32_16x16x32_f16(__builtin_bit_cast(h16x8, a), __builtin_bit_cast(h16x8, b), c, 0, 0, 0); }
__device__ __forceinline__ unsigned pki2(float lo, float hi) { const int a = (int)rintf(fminf(fmaxf(lo * 4096.f, -32767.f), 32767.f)), b = (int)rintf(fminf(fmaxf(hi * 4096.f, -32767.f), 32767.f)); return ((unsigned)a & 0xffffu) | ((unsigned)b << 16); }
__device__ __forceinline__ void unpacki8(u32x4 w, float* o) { const unsigned ww[4] = {w.x, w.y, w.z, w.w};
#pragma unroll
    for (int e = 0; e < 4; ++e) { o[2 * e] = (float)(short)(ww[e] & 0xffffu); o[2 * e + 1] = (float)(short)(ww[e] >> 16); } }
__device__ __forceinline__ float siluf(float x) { return x * __builtin_amdgcn_rcpf(1.f + __expf(-x)); }
__device__ __forceinline__ int il(int t, int m) { return 8 * (m >> 2) + 4 * t + (m & 3); }

constexpr float LO_SCALE = 2048.f;
__device__ __forceinline__ void split8(const float* v, u32x4& hi, u32x4& lo) {
    float r[8]; unsigned h[8];
#pragma unroll
    for (int e = 0; e < 8; ++e) { const _Float16 hh = (_Float16)v[e]; h[e] = (unsigned)__builtin_bit_cast(unsigned short, hh); r[e] = (v[e] - (float)hh) * LO_SCALE; }
    hi.x = h[0] | (h[1] << 16); hi.y = h[2] | (h[3] << 16); hi.z = h[4] | (h[5] << 16); hi.w = h[6] | (h[7] << 16);
    lo.x = pk2(r[0], r[1]); lo.y = pk2(r[2], r[3]); lo.z = pk2(r[4], r[5]); lo.w = pk2(r[6], r[7]);
}
__device__ __forceinline__ void lds_barrier() { asm volatile("s_waitcnt lgkmcnt(0)" ::: "memory"); __builtin_amdgcn_s_barrier(); asm volatile("" ::: "memory"); }
#define SCHED_FENCE() __builtin_amdgcn_sched_barrier(0)
__device__ __forceinline__ int otid() { int t = threadIdx.x; asm volatile("" : "+v"(t)); return t; }
namespace pg8 {
constexpr int BM = 256, BK = 64, HALF = 128, HTB = HALF * BK * 2, STAGE_BYTES = 8 * HTB, NXCD = 8, WGM = 4;
__device__ __forceinline__ int lds_byte(int r, int c) { const int st = (r >> 4) * 2 + (c >> 5), rr = r & 15, cc = c & 31, ob = rr * 64 + cc * 2; return st * 1024 + (ob ^ (((ob >> 9) & 1) << 5)); }
__device__ __forceinline__ void stage_rc(int b, int& R, int& C) { const int st = b / 1024, sb = b % 1024, swz = sb ^ (((sb >> 9) & 1) << 5); R = (st >> 1) * 16 + swz / 64; C = (st & 1) * 32 + (swz % 64) / 2; }
__device__ __forceinline__ int perm32(int rho) { const int n = rho >> 4, i = rho & 15; return 8 * (i >> 2) + 4 * n + (i & 3); }
struct Unit { int pm, pn; };
struct Gemm { const bf16_t* A; const bf16_t* Bt; int M, N, K; };
struct StaticOrder {
    int nM, nN, nwg, G, c;
    __device__ void init(int M, int N, int G_, int c_) { nM = M / BM; nN = N / BM; nwg = nM * nN; G = G_; c = c_; }
    __device__ bool next(int i, Unit& u) const {
        const long L = (long)i * G + c; if (L >= nwg) return false;
        int wgid = (int)L; { const int q = nwg / NXCD, r = nwg % NXCD, xcd = wgid % NXCD, off = wgid / NXCD; wgid = (xcd < r ? xcd * (q + 1) : r * (q + 1) + (xcd - r) * q) + off; }
        const int nig = WGM * nN, gid = wgid / nig, fm = gid * WGM, gsz = (nM - fm) < WGM ? (nM - fm) : WGM;
        u.pm = fm + ((wgid % nig) % gsz); u.pn = (wgid % nig) / gsz; return true;
    }
};

template <class Epi>
__device__ __forceinline__ void gemm_phase(LAS unsigned char* lds, const Gemm g, const StaticOrder& S, const Epi& E) {
    const int tid = otid(), wid = __builtin_amdgcn_readfirstlane(tid >> 6), lane = tid & 63, wr = wid >> 2, wc = wid & 3, fr = lane & 15, fq = lane >> 4;
    const int K = g.K, nt = K / BK;
    unsigned voffA[2], voffB[2];
#pragma unroll
    for (int i = 0; i < 2; ++i) { int R, C; stage_rc(tid * 16 + i * 8192, R, C); const int Rb = Epi::PERM ? ((R & ~31) + perm32(R & 31)) : R;
        voffA[i] = (unsigned)(R * K + C) * 2u; voffB[i] = (unsigned)(Rb * K + C) * 2u; }
    const size_t kstep = (size_t)(BK * 2);
    const size_t hstep = (size_t)HALF * K * 2;
    const size_t tstep = 2 * hstep;
    const unsigned ldsw = (unsigned)wid * 1024u;
    const int aoff = lds_byte(wr * 64 + fr, fq * 8), boff = lds_byte(wc * 32 + fr, fq * 8);
#define PG8_SA(b, h) (((b) * 2 + (h)) * HTB)
#define PG8_SB(b, h) ((4 + (b) * 2 + (h)) * HTB)
#define PG8_STAGE(bufoff, gbase, voff) do { _Pragma("unroll") for (int _i = 0; _i < 2; ++_i) \
        __builtin_amdgcn_global_load_lds((const unsigned*)((const char*)(gbase) + (voff)[_i]), (LAS unsigned*)(lds + (bufoff) + ldsw + _i * 8192), 16, 0, 0); } while (0)
#define PG8_LDA(dst, b, h) do { _Pragma("unroll") for (int m = 0; m < 4; ++m) _Pragma("unroll") for (int k = 0; k < 2; ++k) dst[m][k] = *(const LAS bf16x8*)(lds + PG8_SA(b, h) + aoff + m * 2048 + k * 1024); } while (0)
#define PG8_LDB(dst, b, h) do { _Pragma("unroll") for (int n = 0; n < 2; ++n) _Pragma("unroll") for (int k = 0; k < 2; ++k) dst[n][k] = *(const LAS bf16x8*)(lds + PG8_SB(b, h) + boff + n * 2048 + k * 1024); } while (0)
#define PG8_MMA(ai, bj, At, Bt) do { __builtin_amdgcn_s_setprio(1); _Pragma("unroll") for (int m = 0; m < 4; ++m) _Pragma("unroll") for (int n = 0; n < 2; ++n) _Pragma("unroll") for (int k = 0; k < 2; ++k) \
        acc[ai][bj][m][n] = __builtin_amdgcn_mfma_f32_16x16x32_f16(__builtin_bit_cast(h16x8, Bt[n][k]), __builtin_bit_cast(h16x8, At[m][k]), acc[ai][bj][m][n], 0, 0, 0); __builtin_amdgcn_s_setprio(0); } while (0)
#define PG8_WAIT_V(n) asm volatile("s_waitcnt vmcnt(" #n ")" ::: "memory")
#define PG8_WAIT_L(n) asm volatile("s_waitcnt lgkmcnt(" #n ")" ::: "memory")
#define PG8_BAR __builtin_amdgcn_s_barrier()
#define PG8_SCHED __builtin_amdgcn_sched_barrier(0)
    Unit cur, nxt; int ui = 0;
    if (!S.next(0, cur)) return;
    f32x4 acc[2][2][4][2];
#pragma unroll
    for (int a = 0; a < 2; ++a)
#pragma unroll
        for (int b = 0; b < 2; ++b)
#pragma unroll
            for (int m = 0; m < 4; ++m)
#pragma unroll
                for (int n = 0; n < 2; ++n) acc[a][b][m][n] = (f32x4){0.f, 0.f, 0.f, 0.f};
    bf16x8 At[4][2], B0[2][2], B1[2][2];
    const char* cA = (const char*)g.A + (size_t)cur.pm * tstep; const char* cB = (const char*)g.Bt + (size_t)cur.pn * tstep;
    PG8_STAGE(PG8_SB(0, 0), cB, voffB); PG8_STAGE(PG8_SA(0, 0), cA, voffA); PG8_STAGE(PG8_SB(0, 1), cB + hstep, voffB); PG8_STAGE(PG8_SA(0, 1), cA + hstep, voffA);
    if (wr == 1) PG8_BAR;
    PG8_WAIT_V(4); PG8_BAR;
    PG8_STAGE(PG8_SB(1, 0), cB + kstep, voffB); PG8_STAGE(PG8_SA(1, 0), cA + kstep, voffA); PG8_STAGE(PG8_SB(1, 1), cB + hstep + kstep, voffB);
    PG8_WAIT_V(6); PG8_BAR;
    for (;;) {
        const bool has_next = S.next(ui + 1, nxt);
        const char* nA = has_next ? (const char*)g.A + (size_t)nxt.pm * tstep : cA; const char* nB = has_next ? (const char*)g.Bt + (size_t)nxt.pn * tstep : cB;
        for (int t = 0; t < nt; t += 2) {
            const bool last = (t == nt - 2);
            const char* a1 = cA + (size_t)(t + 1) * kstep;
            const char* a2 = last ? nA : cA + (size_t)(t + 2) * kstep; const char* b2 = last ? nB : cB + (size_t)(t + 2) * kstep;
            const char* a3 = a2 + kstep; const char* b3 = b2 + kstep;
            PG8_LDB(B0, 0, 0); PG8_SCHED; PG8_LDA(At, 0, 0); PG8_STAGE(PG8_SA(1, 1), a1 + hstep, voffA);
            PG8_WAIT_L(8); PG8_BAR; PG8_WAIT_L(0); PG8_MMA(0, 0, At, B0); PG8_BAR; PG8_SCHED;
            PG8_LDB(B1, 0, 1); PG8_STAGE(PG8_SB(0, 0), b2, voffB);
            PG8_BAR; PG8_WAIT_L(0); PG8_MMA(0, 1, At, B1); PG8_BAR;
            PG8_LDA(At, 0, 1); PG8_STAGE(PG8_SA(0, 0), a2, voffA);
            PG8_BAR; PG8_WAIT_L(0); PG8_MMA(1, 0, At, B0); PG8_BAR; PG8_SCHED;
            PG8_STAGE(PG8_SB(0, 1), b2 + hstep, voffB);
            PG8_WAIT_V(6); PG8_BAR; PG8_MMA(1, 1, At, B1); PG8_BAR;
            PG8_LDB(B0, 1, 0); PG8_SCHED; PG8_LDA(At, 1, 0); PG8_STAGE(PG8_SA(0, 1), a2 + hstep, voffA);
            PG8_WAIT_L(8); PG8_BAR; PG8_WAIT_L(0); PG8_MMA(0, 0, At, B0); PG8_BAR; PG8_SCHED;
            PG8_LDB(B1, 1, 1); PG8_STAGE(PG8_SB(1, 0), b3, voffB);
            PG8_BAR; PG8_WAIT_L(0); PG8_MMA(0, 1, At, B1); PG8_BAR;
            PG8_LDA(At, 1, 1); PG8_STAGE(PG8_SA(1, 0), a3, voffA);
            PG8_BAR; PG8_WAIT_L(0); PG8_MMA(1, 0, At, B0); PG8_BAR; PG8_SCHED;
            PG8_STAGE(PG8_SB(1, 1), b3 + hstep, voffB);
            PG8_WAIT_V(6); PG8_BAR; PG8_MMA(1, 1, At, B1); PG8_BAR;
        }
        if constexpr (!Epi::AFTER_DRAIN) E(acc, cur, wr, wc, fr, fq);
        if (!has_next) break;
#pragma unroll
        for (int a = 0; a < 2; ++a)
#pragma unroll
            for (int b = 0; b < 2; ++b)
#pragma unroll
                for (int m = 0; m < 4; ++m)
#pragma unroll
                    for (int n = 0; n < 2; ++n) acc[a][b][m][n] = (f32x4){0.f, 0.f, 0.f, 0.f};
        cur = nxt; cA = nA; cB = nB; ++ui;
    }
    PG8_WAIT_V(0);
    if (wr == 0) PG8_BAR;
    PG8_BAR;
    if constexpr (Epi::AFTER_DRAIN) E.fused(acc, cur, wr, wc, fr, fq, lds, wid, lane);
#undef PG8_SA
#undef PG8_SB
#undef PG8_STAGE
#undef PG8_LDA
#undef PG8_LDB
#undef PG8_MMA
#undef PG8_WAIT_V
#undef PG8_WAIT_L
#undef PG8_BAR
#undef PG8_SCHED
}
}

struct EpiProj {
    static constexpr bool PERM = true, AFTER_DRAIN = false;
    unsigned char* ws;
    __device__ __forceinline__ void operator()(const f32x4 (&acc)[2][2][4][2], const pg8::Unit& u, int wr, int wc, int fr, int fq) const {
        const int pn = u.pn; const int row0 = u.pm * 256 + wr * 64 + fr;
        if (pn < 14) {
            size_t off; int ldc, colt;
            if (pn < 8) { off = (pn >> 1) == 3 ? WS_DNZ : WS_DNQ + (size_t)(pn >> 1) * 16 * MiB; ldc = 512; colt = (pn & 1) * 256; }
            else if (pn == 8) { off = WS_GQ; ldc = 256; colt = 0; }
            else if (pn == 9) { off = WS_GK; ldc = 256; colt = 0; }
            else if (pn < 12) { off = WS_GV; ldc = 512; colt = (pn - 10) * 256; }
            else { off = WS_GZ; ldc = 512; colt = (pn - 12) * 256; }
            bf16_t* base = (bf16_t*)(ws + off);
            const int col0 = colt + wc * 32 + 8 * fq;
#pragma unroll
            for (int ai = 0; ai < 2; ++ai)
#pragma unroll
                for (int m = 0; m < 4; ++m) { bf16_t* rowp = base + (size_t)(row0 + ai * 128 + m * 16) * ldc + col0;
#pragma unroll
                    for (int bj = 0; bj < 2; ++bj) { const f32x4 v0 = acc[ai][bj][m][0], v1 = acc[ai][bj][m][1];
                        u32x4 w;
                        if (pn < 4) { w.x = pki2(v0[0], v0[1]); w.y = pki2(v0[2], v0[3]); w.z = pki2(v1[0], v1[1]); w.w = pki2(v1[2], v1[3]); }
                        else { w.x = pkh2(v0[0], v0[1]); w.y = pkh2(v0[2], v0[3]); w.z = pkh2(v1[0], v1[1]); w.w = pkh2(v1[2], v1[3]); }
                        *(u32x4*)(rowp + bj * 128) = w; } }
        } else if (wc == 0) {
            float* sm = (float*)(ws + WS_SMALL);
#pragma unroll
            for (int ai = 0; ai < 2; ++ai)
#pragma unroll
                for (int m = 0; m < 4; ++m) { float* rowp = sm + (size_t)(row0 + ai * 128 + m * 16) * 32 + 8 * fq;
                    *(f32x4*)(rowp) = acc[ai][0][m][0]; *(f32x4*)(rowp + 4) = acc[ai][0][m][1]; }
        }
    }
};
struct EpiOutLN {
    static constexpr bool PERM = false, AFTER_DRAIN = true;
    const float* resid; float* out; bf16_t* xb; const float* lng; const float* lnb; unsigned* xbuf; unsigned* cnt;
    __device__ __forceinline__ void operator()(const f32x4 (&)[2][2][4][2], const pg8::Unit&, int, int, int, int) const {}
    __device__ __forceinline__ void fused(f32x4 (&acc)[2][2][4][2], const pg8::Unit& u, int wr, int wc, int fr, int fq, LAS unsigned char* lds, int wid, int lane) const {
        typedef float f32x2v __attribute__((ext_vector_type(2)));
        LAS f32x2v* P = (LAS f32x2v*)lds;
        LAS f32x2v* S = (LAS f32x2v*)(lds + 8192);
        const int col0 = u.pn * 256 + wc * 32 + 4 * fq;
        f32x4 rb[2][4];
#pragma unroll
        for (int i = 0; i < 4; ++i) rb[0][i] = __builtin_nontemporal_load((const f32x4*)(resid + (size_t)(u.pm * 256 + wr * 64 + fr) * DM + col0 + (i >> 1) * 128 + (i & 1) * 16));
#pragma unroll
        for (int g = 0; g < 8; ++g) {
            const int ai = g >> 2, m = g & 3;
            if (g + 1 < 8) { const int ai1 = (g + 1) >> 2, m1 = (g + 1) & 3; const size_t off1 = (size_t)(u.pm * 256 + ai1 * 128 + wr * 64 + m1 * 16 + fr) * DM + col0;
#pragma unroll
                for (int i = 0; i < 4; ++i) rb[(g + 1) & 1][i] = __builtin_nontemporal_load((const f32x4*)(resid + off1 + (i >> 1) * 128 + (i & 1) * 16)); }
#pragma unroll
            for (int i = 0; i < 4; ++i) acc[ai][i >> 1][m][i & 1] = rb[g & 1][i] * DEEP_ALPHA + acc[ai][i >> 1][m][i & 1];
            asm volatile("" : "+v"(acc[ai][0][m][0]), "+v"(acc[ai][0][m][1]), "+v"(acc[ai][1][m][0]), "+v"(acc[ai][1][m][1]));
            SCHED_FENCE();
        }
#pragma unroll
        for (int ai = 0; ai < 2; ++ai)
#pragma unroll
            for (int m = 0; m < 4; ++m) {
                float s = 0.f;
#pragma unroll
                for (int bj = 0; bj < 2; ++bj)
#pragma unroll
                    for (int n = 0; n < 2; ++n) { const f32x4 x = acc[ai][bj][m][n]; s += (x[0] + x[1]) + (x[2] + x[3]); }
                s += __shfl_xor(s, 16); s += __shfl_xor(s, 32);
                const float mw = s * (1.0f / 64.0f); float qq = 0.f;
#pragma unroll
                for (int bj = 0; bj < 2; ++bj)
#pragma unroll
                    for (int n = 0; n < 2; ++n) { const f32x4 d = acc[ai][bj][m][n] - mw; qq += (d[0] * d[0] + d[1] * d[1]) + (d[2] * d[2] + d[3] * d[3]); }
                qq += __shfl_xor(qq, 16); qq += __shfl_xor(qq, 32);
                if (fq == 0) P[(ai * 128 + wr * 64 + m * 16 + fr) * 4 + wc] = (f32x2v){mw, qq};
            }
        asm volatile("s_waitcnt lgkmcnt(0)" ::: "memory"); __builtin_amdgcn_s_barrier(); asm volatile("" ::: "memory");
        const int row = wid * 32 + (lane & 31);
        if (lane < 32) {
            const f32x2v pa = P[row * 4 + 0], pb = P[row * 4 + 1], pc = P[row * 4 + 2], pd = P[row * 4 + 3];
            const float mt = (pa.x + pb.x + pc.x + pd.x) * 0.25f;
            const float da = pa.x - mt, db = pb.x - mt, dc = pc.x - mt, dd = pd.x - mt;
            const float m2 = (pa.y + pb.y) + (pc.y + pd.y) + 64.0f * ((da * da + db * db) + (dc * dc + dd * dd));
            unsigned long long* slot = (unsigned long long*)xbuf + ((size_t)(u.pm * 256 + row) * 4 + u.pn);
            __hip_atomic_store(slot, ((unsigned long long)__float_as_uint(m2) << 32) | __float_as_uint(mt), __ATOMIC_RELAXED, __HIP_MEMORY_SCOPE_AGENT);
        }
        asm volatile("s_waitcnt vmcnt(0)" ::: "memory");
        if (lane == 0) __hip_atomic_fetch_add(cnt + 64 * u.pm, 1u, __ATOMIC_RELAXED, __HIP_MEMORY_SCOPE_AGENT);
        if (wid == 0) {
            unsigned sp = 0;
            while ((unsigned)__builtin_amdgcn_readfirstlane(__hip_atomic_load(cnt + 64 * u.pm, __ATOMIC_RELAXED, __HIP_MEMORY_SCOPE_AGENT)) < 32u) { __builtin_amdgcn_s_sleep(2); if (++sp > (1u << 24)) break; }
            __builtin_amdgcn_fence(__ATOMIC_ACQUIRE, "agent");
        }
        asm volatile("s_waitcnt vmcnt(0) lgkmcnt(0)" ::: "memory"); __builtin_amdgcn_s_barrier(); asm volatile("" ::: "memory");
        if (lane < 32) {
            const unsigned long long* slot = (const unsigned long long*)xbuf + (size_t)(u.pm * 256 + row) * 4; float mt[4], m2[4]; float ms = 0.f;
#pragma unroll
            for (int t = 0; t < 4; ++t) { const unsigned long long wv = __hip_atomic_load(slot + t, __ATOMIC_RELAXED, __HIP_MEMORY_SCOPE_AGENT); mt[t] = __uint_as_float((unsigned)wv); m2[t] = __uint_as_float((unsigned)(wv >> 32)); ms += mt[t]; }
            const float mean = ms * 0.25f; float qq = 0.f;
#pragma unroll
            for (int t = 0; t < 4; ++t) { const float dm = mt[t] - mean; qq += m2[t] + 256.0f * dm * dm; }
            S[row] = (f32x2v){mean, rsqrtf(qq * (1.0f / 1024.0f) + EPS)};
        }
        asm volatile("s_waitcnt lgkmcnt(0)" ::: "memory"); __builtin_amdgcn_s_barrier(); asm volatile("" ::: "memory");
#pragma unroll
        for (int ai = 0; ai < 2; ++ai)
#pragma unroll
            for (int m = 0; m < 4; ++m) { const int r = ai * 128 + wr * 64 + m * 16 + fr; const f32x2v sr = S[r]; const size_t off = (size_t)(u.pm * 256 + r) * DM + col0;
#pragma unroll
                for (int bj = 0; bj < 2; ++bj)
#pragma unroll
                    for (int n = 0; n < 2; ++n) { const f32x4 gg = *(const f32x4*)(lng + col0 + bj * 128 + n * 16), bb = *(const f32x4*)(lnb + col0 + bj * 128 + n * 16);
                        const f32x4 o = (acc[ai][bj][m][n] - sr.x) * sr.y * gg + bb;
                        __builtin_nontemporal_store(o, (f32x4*)(out + off + bj * 128 + n * 16));
                        if (xb) { u32x2 wv; wv.x = pkh2(o[0], o[1]); wv.y = pkh2(o[2], o[3]); *(u32x2*)(xb + off + bj * 128 + n * 16) = wv; } }
                SCHED_FENCE(); }
    }
};

#define XB_TMO      128
#define XB_XCNT(j)  (256  + 64 * (j))
#define XB_XSUB(j)  (1280 + 64 * (j))
#define XB_XGEN(j)  (2304 + 64 * (j))
#define XB_TOP      3328
#define XB_TOPGEN   3392
#define XCD_BAR_WORDS 3456
#define XB_SPIN_CAP (1u << 22)
__device__ __forceinline__ unsigned xb_ld(unsigned* p)              { return __hip_atomic_load(p, __ATOMIC_RELAXED, __HIP_MEMORY_SCOPE_AGENT); }
__device__ __forceinline__ unsigned xb_add(unsigned* p, unsigned v) { return __hip_atomic_fetch_add(p, v, __ATOMIC_RELAXED, __HIP_MEMORY_SCOPE_AGENT); }
__device__ __forceinline__ unsigned xb_xcc_id() { return (unsigned)__builtin_amdgcn_s_getreg((3 << 11) | 20) & 0xFu; }
#define XB_SPIN(cond, bar) do { unsigned _sp = 0; while (cond) { __builtin_amdgcn_s_sleep(4); \
    if ((++_sp & 255u) == 0u) { if (xb_ld(&(bar)[XB_TMO])) break; if (_sp > XB_SPIN_CAP) { atomicAdd(&(bar)[XB_TMO], 1u); break; } } } } while (0)
struct XcdBarrier { unsigned* bar; unsigned x; volatile LAS unsigned* st; };
__device__ __forceinline__ XcdBarrier xcd_barrier_post(unsigned* bar, volatile LAS unsigned* st) {
    XcdBarrier b; b.bar = bar; b.x = xb_xcc_id(); b.st = st;
    if (threadIdx.x == 0) (void)xb_add(&bar[XB_XCNT(b.x)], 1u);
    return b;
}
__device__ __forceinline__ void xcd_barrier_complete(unsigned* bar, unsigned x, unsigned& nloc, unsigned& nx) {
    const unsigned G = gridDim.x * gridDim.y * gridDim.z;
    unsigned sum, cnt, mine, sp = 0u;
    for (;;) {
        sum = 0u; cnt = 0u; mine = 0u;
#pragma unroll
        for (unsigned j = 0; j < 16; ++j) { const unsigned c = xb_ld(&bar[XB_XCNT(j)]); sum += c; cnt += (c > 0u) ? 1u : 0u; mine = (j == x) ? c : mine; }
        if (sum == G) break;
        __builtin_amdgcn_s_sleep(1);
        if ((++sp & 255u) == 0u) { if (xb_ld(&bar[XB_TMO])) break; if (sp > XB_SPIN_CAP) { atomicAdd(&bar[XB_TMO], 1u); break; } }
    }
    nloc = mine > 0u ? mine : 1u; nx = cnt > 0u ? cnt : 1u;
}
__device__ __forceinline__ void xcd_barrier(const XcdBarrier& b) {
    asm volatile("s_waitcnt vmcnt(0)" ::: "memory");
    __syncthreads();
    if (threadIdx.x == 0) {
        unsigned* bar = b.bar;
        __builtin_amdgcn_s_waitcnt(0);
        unsigned nloc = b.st[0], nx = b.st[1];
        if (nloc == 0u) { xcd_barrier_complete(bar, b.x, nloc, nx); b.st[0] = nloc; b.st[1] = nx; }
        const unsigned old = xb_add(&bar[XB_XSUB(b.x)], 1u);
        const unsigned gen = old / nloc;
        if (old + 1u == (gen + 1u) * nloc) {
            __builtin_amdgcn_fence(__ATOMIC_RELEASE, "agent");
            asm volatile("s_waitcnt vmcnt(0)" ::: "memory");
            const unsigned og = xb_add(&bar[XB_TOP], 1u);
            const unsigned tg = og / nx;
            if (og + 1u == (tg + 1u) * nx) xb_add(&bar[XB_TOPGEN], 1u);
            else XB_SPIN(xb_ld(&bar[XB_TOPGEN]) == tg, bar);
            __builtin_amdgcn_fence(__ATOMIC_ACQUIRE, "agent");
            xb_add(&bar[XB_XGEN(b.x)], 1u);
            asm volatile("s_waitcnt vmcnt(0)" ::: "memory");
        } else {
            XB_SPIN(xb_ld(&bar[XB_XGEN(b.x)]) == gen, bar);
            __builtin_amdgcn_fence(__ATOMIC_ACQUIRE, "agent");
            asm volatile("s_waitcnt vmcnt(0)" ::: "memory");
        }
    }
    __syncthreads();
}
constexpr size_t WS_BAR = 524288;

struct Args {
    const float *x, *w_in, *conv_w, *a_log, *dt_bias, *gw2, *gb, *dn_g, *gla_g, *w_out, *ln_g, *ln_b;
    float* out; unsigned char* ws; int ph_lo, ph_hi;
};

__device__ __forceinline__ int win_src_col(int r) { return r < 2048 ? r : (r < 3584 ? r + 8 : (r < 3592 ? r - 1536 : (r < 3608 ? r : -1))); }
template <bool MAP>
__device__ __forceinline__ void transpose_item(const float* W, int ldw, bf16_t* WT, int nblk, float* scr, int item, int lane) {
    const int kb = item / nblk, nb = item % nblk, k0 = 64 * kb, n0 = 32 * nb;
    const int kk = lane >> 3, n4 = lane & 7;
    const int sc = MAP ? win_src_col(n0 + 4 * n4) : n0 + 4 * n4;
    f32x4 v[8];
#pragma unroll
    for (int i = 0; i < 8; ++i) v[i] = sc >= 0 ? __builtin_nontemporal_load((const f32x4*)(W + (size_t)(k0 + 8 * i + kk) * ldw + sc)) : (f32x4){0.f, 0.f, 0.f, 0.f};
#pragma unroll
    for (int i = 0; i < 8; ++i) { float* s = scr + (8 * i + kk) * 33 + 4 * n4; s[0] = v[i][0]; s[1] = v[i][1]; s[2] = v[i][2]; s[3] = v[i][3]; }
    asm volatile("s_waitcnt lgkmcnt(0)" ::: "memory");
    const int c = lane & 7;
#pragma unroll
    for (int j = 0; j < 4; ++j) { const int n = (lane >> 3) + 8 * j; const float* s = scr + (8 * c) * 33 + n;
        u32x4 o; o.x = pkh2(s[0 * 33], s[1 * 33]); o.y = pkh2(s[2 * 33], s[3 * 33]); o.z = pkh2(s[4 * 33], s[5 * 33]); o.w = pkh2(s[6 * 33], s[7 * 33]);
        *(u32x4*)(WT + (size_t)(n0 + n) * 1024 + k0 + 8 * c) = o; }
    asm volatile("s_waitcnt lgkmcnt(0)" ::: "memory");
}

__device__ __forceinline__ void convert_weights(const Args& a, int l, int gw, int ngw, float* scr, int lane) {
    constexpr int I_IN = 16 * (NPROJ / 32), I_OUT = 16 * 32;
    for (int r = gw; r < I_IN + I_OUT; r += ngw) {
        if (r < I_IN) transpose_item<true>(a.w_in + (size_t)l * DM * 3608, 3608, (bf16_t*)(a.ws + WS_WIN + l * WIN_BYTES), NPROJ / 32, scr, r, lane);
        else transpose_item<false>(a.w_out + (size_t)l * DM * DM, DM, (bf16_t*)(a.ws + WS_WOUT + l * WOUT_BYTES), 32, scr, r - I_IN, lane);
    }
}
__device__ __forceinline__ void prologue(const Args& a, unsigned char* lds) {
    const int tid = otid(), lane = tid & 63, wave = tid >> 6, G = gridDim.x;
    float* scr = (float*)(lds + wave * 8448);
    const int gw = blockIdx.x * 8 + wave, NGW = G * 8;
    convert_weights(a, 0, gw, NGW, scr, lane);
    const size_t n8 = (size_t)MROWS * DM / 8;
    u32x4* xb = (u32x4*)(a.ws + WS_XB);
    for (size_t i = (size_t)blockIdx.x * 512 + tid; i < n8; i += (size_t)G * 512) {
        const f32x4 v0 = __builtin_nontemporal_load((const f32x4*)a.x + 2 * i), v1 = __builtin_nontemporal_load((const f32x4*)a.x + 2 * i + 1);
        u32x4 w; w.x = pkh2(v0[0], v0[1]); w.y = pkh2(v0[2], v0[3]); w.z = pkh2(v1[0], v1[1]); w.w = pkh2(v1[2], v1[3]); xb[i] = w;
    }
}

constexpr int L_KS = 0, L_QS = 17408, L_RT = 34816, L_AF = 71680, L_TB = 89088, L_KD = 98304, L_SG = 116736, L_QL = 117248, L_KL = 134656, L_CW = 152064;
__device__ __forceinline__ void load5(const bf16_t* raw, int tloc, u32x4* rows) {
#pragma unroll
    for (int r = 0; r < 5; ++r) rows[r] = (tloc + r - 3 >= 0) ? *(const u32x4*)(raw + (ptrdiff_t)(r - 3) * 512) : (u32x4){0u, 0u, 0u, 0u};
}
template <bool I16>
__device__ __forceinline__ void conv2(const u32x4* rows, const float* cw, float* o0, float* o1) {
    float xr[5][8];
#pragma unroll
    for (int r = 0; r < 5; ++r) { if (I16) unpacki8(rows[r], xr[r]); else unpackh8(rows[r], xr[r]); }
#pragma unroll
    for (int e = 0; e < 8; ++e) { o0[e] = 0.f; o1[e] = 0.f; }
#pragma unroll
    for (int tap = 0; tap < 4; ++tap) {
        const f32x4 w0 = *(const f32x4*)(cw + tap * 128), w1 = *(const f32x4*)(cw + tap * 128 + 4);
#pragma unroll
        for (int e = 0; e < 4; ++e) { o0[e] += w0[e] * xr[tap][e]; o0[4 + e] += w1[e] * xr[tap][4 + e]; o1[e] += w0[e] * xr[tap + 1][e]; o1[4 + e] += w1[e] * xr[tap + 1][4 + e]; }
    }
#pragma unroll
    for (int e = 0; e < 8; ++e) { o0[e] = siluf(o0[e]); o1[e] = siluf(o1[e]); }
}
__device__ __forceinline__ float sum16(float v) { v += __shfl_xor(v, 1); v += __shfl_xor(v, 2); v += __shfl_xor(v, 4); v += __shfl_xor(v, 8); return v; }

struct DnPre { u32x4 rq[5]; float bl, al; };
__device__ __forceinline__ void dn_preload(const Args& a, int task, int tid, DnPre& p) {
    const int bh = task >> 5, n = task & 31, b = bh >> 2, h = bh & 3; const size_t tok0 = (size_t)b * SEQ + 64 * n;
    const int tp = tid >> 4, c = tid & 15, t0 = 2 * tp; const size_t ro = (tok0 + t0) * 512 + 128 * h + 8 * c;
    load5((const bf16_t*)(a.ws + WS_DNQ) + ro, 64 * n + t0, p.rq);
    if (tid < 64) { const float* sm = (const float*)(a.ws + WS_SMALL) + (tok0 + tid) * 32; p.bl = sm[h]; p.al = sm[4 + h]; }
}
__device__ __forceinline__ void dn_prep(const Args& a, int l, int task, int next, DnPre& P, float dtb, float nexpa, unsigned char* lds) {
    const int tid = otid(), lane = tid & 63, wave = __builtin_amdgcn_readfirstlane(tid >> 6), m = lane & 15, q = lane >> 4;
    const int bh = task >> 5, n = task & 31, b = bh >> 2, h = bh & 3;
    unsigned char* ws = a.ws;
    bf16_t* KS = (bf16_t*)(lds + L_KS); bf16_t* QS = (bf16_t*)(lds + L_QS); bf16_t* RT = (bf16_t*)(lds + L_RT);
    float* AF = (float*)(lds + L_AF); bf16_t* TB = (bf16_t*)(lds + L_TB); bf16_t* KD = (bf16_t*)(lds + L_KD); float* SG = (float*)(lds + L_SG);
    bf16_t* QL = (bf16_t*)(lds + L_QL); bf16_t* KL = (bf16_t*)(lds + L_KL);
    const size_t tok0 = (size_t)b * SEQ + 64 * n;
    u32x4 rq[5], rk[5], rv[5];
#pragma unroll
    for (int r = 0; r < 5; ++r) rq[r] = P.rq[r];
    { const int tp = tid >> 4, c = tid & 15, t0 = 2 * tp; const size_t ro = ((size_t)b * SEQ + 64 * n + t0) * 512 + 128 * h + 8 * c;
      load5((const bf16_t*)(ws + WS_DNK) + ro, 64 * n + t0, rk); load5((const bf16_t*)(ws + WS_DNV) + ro, 64 * n + t0, rv); }
    if (wave == 0) {
        const float bl = P.bl, al = P.al;
        const float beta = __builtin_amdgcn_rcpf(1.f + __expf(-bl));
        const float xs = al + dtb;
        const float ee = __expf(-fabsf(xs));
        const float l1p = ee < 0.03f ? ee * (1.f - ee * (0.5f - ee * 0.33333333f)) : __logf(1.f + ee);
        const float sp = fmaxf(xs, 0.f) + l1p;
        float g = nexpa * sp;
#pragma unroll
        for (int o = 1; o < 64; o <<= 1) { const float t = __shfl_up(g, o); if (lane >= o) g += t; }
        SG[lane] = g; SG[64 + lane] = beta;
    }
    lds_barrier();
    {
        const int tp = tid >> 4, c = tid & 15, t0 = 2 * tp;
        const float G0 = SG[t0], G1 = SG[t0 + 1], be0 = SG[64 + t0], be1 = SG[64 + t0 + 1], Gl = SG[63];
        const int tsw = 2 * (tp ^ (4 * (c & 7)));
        const float* cw = (const float*)(lds + L_CW) + 8 * c;
        float o0[8], o1[8];
        conv2<true>(rq, cw, o0, o1);
        {
            float s0 = 0.f, s1 = 0.f;
#pragma unroll
            for (int e = 0; e < 8; ++e) { s0 += o0[e] * o0[e]; s1 += o1[e] * o1[e]; }
            s0 = sum16(s0); s1 = sum16(s1);
            const float r0 = rsqrtf(s0 + EPS) * 0.08838834764831845f, r1 = rsqrtf(s1 + EPS) * 0.08838834764831845f;
            u32x4 w0, w1, g0, g1; const float e0 = __expf(G0) * 128.f, e1 = __expf(G1) * 128.f;
#pragma unroll
            for (int e = 0; e < 8; ++e) { o0[e] *= r0; o1[e] *= r1; }
            { u32x4 l0, l1; split8(o0, w0, l0); split8(o1, w1, l1); *(u32x4*)(QL + t0 * 136 + 8 * c) = l0; *(u32x4*)(QL + (t0 + 1) * 136 + 8 * c) = l1; }
            *(u32x4*)(QS + t0 * 136 + 8 * c) = w0; *(u32x4*)(QS + (t0 + 1) * 136 + 8 * c) = w1;
            g0.x = pk2(o0[0] * e0, o0[1] * e0); g0.y = pk2(o0[2] * e0, o0[3] * e0); g0.z = pk2(o0[4] * e0, o0[5] * e0); g0.w = pk2(o0[6] * e0, o0[7] * e0);
            g1.x = pk2(o1[0] * e1, o1[1] * e1); g1.y = pk2(o1[2] * e1, o1[3] * e1); g1.z = pk2(o1[4] * e1, o1[5] * e1); g1.w = pk2(o1[6] * e1, o1[7] * e1);
            bf16_t* qt = (bf16_t*)(ws + WS_DQT) + (size_t)task * 8192;
            *(u32x4*)(qt + t0 * 128 + 8 * c) = g0; *(u32x4*)(qt + (t0 + 1) * 128 + 8 * c) = g1;
        }
        conv2<true>(rk, cw + 512, o0, o1);
        {
            float s0 = 0.f, s1 = 0.f;
#pragma unroll
            for (int e = 0; e < 8; ++e) { s0 += o0[e] * o0[e]; s1 += o1[e] * o1[e]; }
            s0 = sum16(s0); s1 = sum16(s1);
            const float r0 = rsqrtf(s0 + EPS), r1 = rsqrtf(s1 + EPS);
#pragma unroll
            for (int e = 0; e < 8; ++e) { o0[e] *= r0; o1[e] *= r1; }
            u32x4 w0, w1;
            { u32x4 l0, l1; split8(o0, w0, l0); split8(o1, w1, l1); *(u32x4*)(KL + t0 * 136 + 8 * c) = l0; *(u32x4*)(KL + (t0 + 1) * 136 + 8 * c) = l1; }
            *(u32x4*)(KS + t0 * 136 + 8 * c) = w0; *(u32x4*)(KS + (t0 + 1) * 136 + 8 * c) = w1;
            const float kb0 = be0 * __expf(G0), kb1 = be1 * __expf(G1), kd0 = __expf(Gl - G0), kd1 = __expf(Gl - G1);
#pragma unroll
            for (int e = 0; e < 8; ++e) {
                *(unsigned*)(RT + (128 + 8 * c + e) * 72 + tsw) = pk2(o0[e] * kb0, o1[e] * kb1);
                *(unsigned*)(KD + (8 * c + e) * 72 + tsw) = pk2(o0[e] * kd0, o1[e] * kd1);
            }
        }
        conv2<false>(rv, cw + 1024, o0, o1);
#pragma unroll
        for (int e = 0; e < 8; ++e) *(unsigned*)(RT + (8 * c + e) * 72 + tsw) = pk2(o0[e] * be0, o1[e] * be1);
    }
    lds_barrier();
    if (next >= 0) dn_preload(a, next, tid, P);
    {
        bf16_t* att = (bf16_t*)(ws + WS_DATT) + (size_t)task * 4096;
        const int na = wave < 2 ? 2 : 1;
        for (int ja = 0; ja < na; ++ja) {
            const int aa = wave + 8 * ja;
            const int Tj = aa < 4 ? 0 : (aa < 7 ? 1 : (aa < 9 ? 2 : 3)), Ti = aa - (Tj == 0 ? 0 : (Tj == 1 ? 3 : (Tj == 2 ? 5 : 6)));
            f32x4 acc = {0.f, 0.f, 0.f, 0.f}, accl = {0.f, 0.f, 0.f, 0.f};
            bf16x8 fav[4], fbv[4], fal[4], fbl[4];
#pragma unroll
            for (int ks = 0; ks < 4; ++ks) {
                fav[ks] = *(const bf16x8*)(KS + (16 * Tj + m) * 136 + 32 * ks + 8 * q); fbv[ks] = *(const bf16x8*)(QS + (16 * Ti + m) * 136 + 32 * ks + 8 * q);
                fal[ks] = *(const bf16x8*)(KL + (16 * Tj + m) * 136 + 32 * ks + 8 * q); fbl[ks] = *(const bf16x8*)(QL + (16 * Ti + m) * 136 + 32 * ks + 8 * q);
            }
            SCHED_FENCE();
#pragma unroll
            for (int ks = 0; ks < 4; ++ks) { accl = mfma16(fal[ks], fbv[ks], accl); acc = mfma16(fav[ks], fbv[ks], acc); accl = mfma16(fav[ks], fbl[ks], accl); }
            acc = acc + accl * (1.f / LO_SCALE);
            const int i = 16 * Ti + m; const float Gi = SG[i]; float v[4];
#pragma unroll
            for (int r = 0; r < 4; ++r) { const int j = 16 * Tj + 4 * q + r; v[r] = (i >= j) ? acc[r] * (128.f * __expf(Gi - SG[j])) : 0.f; }
            u32x2 w; w.x = pk2(v[0], v[1]); w.y = pk2(v[2], v[3]);
            *(u32x2*)(att + i * 64 + 16 * Tj + 4 * q) = w;
        }
        const int nk = wave < 2 ? 0 : (wave < 6 ? 2 : 1), k0 = wave < 6 ? 2 * (wave - 2) : 8 + (wave - 6);
        for (int jk = 0; jk < nk; ++jk) {
            const int kk = k0 + jk;
            const int Ti = kk < 1 ? 0 : (kk < 3 ? 1 : (kk < 6 ? 2 : 3)), Tj = kk - (Ti == 0 ? 0 : (Ti == 1 ? 1 : (Ti == 2 ? 3 : 6)));
            f32x4 acc = {0.f, 0.f, 0.f, 0.f};
            bf16x8 fa[4], fb[4];
#pragma unroll
            for (int ks = 0; ks < 4; ++ks) { fa[ks] = *(const bf16x8*)(KS + (16 * Ti + m) * 136 + 32 * ks + 8 * q); fb[ks] = *(const bf16x8*)(KS + (16 * Tj + m) * 136 + 32 * ks + 8 * q); }
            SCHED_FENCE();
#pragma unroll
            for (int ks = 0; ks < 4; ++ks) acc = mfma16(fa[ks], fb[ks], acc);
            const int j = 16 * Tj + m; const float Gj = SG[j];
#pragma unroll
            for (int r = 0; r < 4; ++r) { const int i = 16 * Ti + 4 * q + r; AF[i * 68 + j] = (i > j) ? SG[64 + i] * acc[r] * __expf(SG[i] - Gj) : 0.f; }
        }
        if (wave >= 6) {
            for (int jz = 0; jz < 3; ++jz) {
                const int z = 3 * (wave - 6) + jz;
                const int Tj = z < 1 ? 1 : (z < 3 ? 2 : 3), Ti = z - (Tj == 1 ? 0 : (Tj == 2 ? 1 : 3));
                *(u32x2*)(att + (16 * Ti + m) * 64 + 16 * Tj + 4 * q) = (u32x2){0u, 0u};
            }
        }
    }
    lds_barrier();
    {
        bf16_t* kdt = (bf16_t*)(ws + WS_KDT) + (size_t)task * 8192;
        for (int idx = tid; idx < 1024; idx += 512) { const int row = idx >> 3, ch = idx & 7; *(u32x4*)(kdt + row * 64 + 8 * ch) = *(const u32x4*)(KD + row * 72 + 8 * (ch ^ ((row >> 3) & 7))); }
        if (tid == 0) ((float*)(ws + WS_EGL))[task] = expf(SG[63]);
        int vz; asm volatile("v_mov_b32 %0, 0" : "=v"(vz));
        const float* AFv = AF + vz;
        float* TL = (float*)(lds + L_QS);
        float* OFF = (float*)(lds + L_KS);
        float* DINV = (float*)(lds + L_KS + 4096);
        if (wave == 0) {
            const int I = lane >> 4, c = lane & 15;
            const float* Ad = AF + (16 * I) * 68 + 16 * I;
            float d[16];
#pragma unroll
            for (int r = 0; r < 16; ++r) {
                float acc = (r == c) ? 1.f : 0.f;
#pragma unroll
                for (int r4 = 0; r4 < (r + 3) / 4; ++r4) {
                    const f32x4 av = *(const f32x4*)(Ad + r * 68 + 4 * r4);
                    if (4 * r4 + 0 < r) acc -= av[0] * d[4 * r4 + 0];
                    if (4 * r4 + 1 < r) acc -= av[1] * d[4 * r4 + 1];
                    if (4 * r4 + 2 < r) acc -= av[2] * d[4 * r4 + 2];
                    if (4 * r4 + 3 < r) acc -= av[3] * d[4 * r4 + 3];
                }
                d[r] = acc;
                DINV[(I * 16 + r) * 16 + c] = acc;
            }
        }
        lds_barrier();
#pragma unroll 1
        for (int I = 0; I < 4; ++I) {
            {
                const int r0 = 16 * I + 2 * wave;
                float s0 = (r0 == lane) ? 1.f : 0.f, s1 = (r0 + 1 == lane) ? 1.f : 0.f;
#pragma unroll 4
                for (int j = 0; j < 16 * I; j += 4) {
                    const float t0 = TL[(j + 0) * 64 + lane], t1 = TL[(j + 1) * 64 + lane], t2 = TL[(j + 2) * 64 + lane], t3 = TL[(j + 3) * 64 + lane];
                    const f32x4 a0 = *(const f32x4*)(AFv + r0 * 68 + j), a1 = *(const f32x4*)(AFv + (r0 + 1) * 68 + j);
                    s0 -= (a0[0] * t0 + a0[1] * t1) + (a0[2] * t2 + a0[3] * t3);
                    s1 -= (a1[0] * t0 + a1[1] * t1) + (a1[2] * t2 + a1[3] * t3);
                }
                OFF[(2 * wave) * 64 + lane] = s0; OFF[(2 * wave + 1) * 64 + lane] = s1;
            }
            lds_barrier();
            {
                const float* Dv = DINV + vz + (I * 16 + 2 * wave) * 16;
                float x[16];
#pragma unroll
                for (int r2 = 0; r2 < 16; ++r2) x[r2] = OFF[r2 * 64 + lane];
                float ta = 0.f, tb = 0.f;
#pragma unroll
                for (int r4 = 0; r4 < 4; ++r4) {
                    const f32x4 da = *(const f32x4*)(Dv + 4 * r4), db = *(const f32x4*)(Dv + 16 + 4 * r4);
                    ta += (da[0] * x[4 * r4] + da[1] * x[4 * r4 + 1]) + (da[2] * x[4 * r4 + 2] + da[3] * x[4 * r4 + 3]);
                    tb += (db[0] * x[4 * r4] + db[1] * x[4 * r4 + 1]) + (db[2] * x[4 * r4 + 2] + db[3] * x[4 * r4 + 3]);
                }
                const int ra = 16 * I + 2 * wave;
                TL[ra * 64 + lane] = ta; TL[(ra + 1) * 64 + lane] = tb;
                TB[ra * 72 + lane] = (bf16_t)f2bf(ta); TB[(ra + 1) * 72 + lane] = (bf16_t)f2bf(tb);
            }
            lds_barrier();
        }
    }
    {
        bf16_t* ut = (bf16_t*)(ws + WS_UT) + (size_t)task * 8192;
        {
            const int swb = (2 * wave + (m >> 3)) & 7;
            bf16x8 bv[2], fa[8];
#pragma unroll
            for (int s = 0; s < 2; ++s) bv[s] = *(const bf16x8*)(RT + (16 * wave + m) * 72 + 8 * ((4 * s + q) ^ swb));
#pragma unroll
            for (int i = 0; i < 8; ++i) { const int P = i >> 2, s = (i >> 1) & 1, t = i & 1; fa[i] = *(const bf16x8*)(TB + (32 * P + il(t, m)) * 72 + 32 * s + 8 * q); }
            SCHED_FENCE();
#pragma unroll
            for (int P = 0; P < 2; ++P) {
                f32x4 c0 = {0.f, 0.f, 0.f, 0.f}, c1 = {0.f, 0.f, 0.f, 0.f};
#pragma unroll
                for (int s = 0; s < 2; ++s) { c0 = mfma16(fa[4 * P + 2 * s], bv[s], c0); c1 = mfma16(fa[4 * P + 2 * s + 1], bv[s], c1); }
                *(bf16x8*)(ut + (16 * wave + m) * 64 + 32 * P + 8 * q) = pack8(c0, c1);
            }
        }
        bf16_t* nw = (bf16_t*)(ws + WS_NEGW) + (size_t)task * 8192;
        {
            const int Pd = wave >> 1, swa = (4 * Pd + (m >> 2)) & 7;
            bf16x8 fb[4], fa[4];
#pragma unroll
            for (int i = 0; i < 4; ++i) { const int tt = i >> 1, s = i & 1; fb[i] = *(const bf16x8*)(TB + (16 * (2 * (wave & 1) + tt) + m) * 72 + 32 * s + 8 * q); }
#pragma unroll
            for (int i = 0; i < 4; ++i) { const int s = i >> 1, t = i & 1; fa[i] = *(const bf16x8*)(RT + (128 + 32 * Pd + il(t, m)) * 72 + 8 * ((4 * s + q) ^ swa)); }
            SCHED_FENCE();
#pragma unroll
            for (int tt = 0; tt < 2; ++tt) {
                const int Ti = 2 * (wave & 1) + tt;
                f32x4 c0 = {0.f, 0.f, 0.f, 0.f}, c1 = {0.f, 0.f, 0.f, 0.f};
#pragma unroll
                for (int s = 0; s < 2; ++s) { c0 = mfma16(fa[2 * s], fb[2 * tt + s], c0); c1 = mfma16(fa[2 * s + 1], fb[2 * tt + s], c1); }
                *(bf16x8*)(nw + (16 * Ti + m) * 128 + 32 * Pd + 8 * q) = pack8(-c0, -c1);
            }
        }
    }
    lds_barrier();
}

constexpr int G_QS = 0, G_KS = 9216, G_KDT = 18432, G_VT = 27648, G_TOT = 46080, G_GR = 48128, G_W2 = 52224;
__device__ __forceinline__ void gla_prep(const Args& a, int l, int task, unsigned char* lds) {
    const int tid = otid(), lane = tid & 63, wave = __builtin_amdgcn_readfirstlane(tid >> 6), m = lane & 15, q = lane >> 4;
    const int bh = task >> 5, n = task & 31, b = bh >> 2, h = bh & 3;
    unsigned char* ws = a.ws;
    bf16_t* QS = (bf16_t*)(lds + G_QS); bf16_t* KS = (bf16_t*)(lds + G_KS); bf16_t* KDT = (bf16_t*)(lds + G_KDT); bf16_t* VT = (bf16_t*)(lds + G_VT);
    float* TOT = (float*)(lds + G_TOT);
    const size_t tok0 = (size_t)b * SEQ + 64 * n;
    const int d = lane, tg = wave;
    float* GR = (float*)(lds + G_GR);
    f32x4 grv;
    if (tid < 256) grv = *(const f32x4*)((const float*)(ws + WS_SMALL) + (tok0 + (tid >> 2)) * 32 + 8 + 4 * (tid & 3));
    float c[8];
    bf16_t qraw[8], kraw[8];
    {
        const bf16_t* qp = (const bf16_t*)(ws + WS_GQ) + (tok0 + 8 * tg) * 256 + 64 * h + d;
        const bf16_t* kp = (const bf16_t*)(ws + WS_GK) + (tok0 + 8 * tg) * 256 + 64 * h + d;
#pragma unroll
        for (int tt = 0; tt < 8; ++tt) { qraw[tt] = qp[tt * 256]; kraw[tt] = kp[tt * 256]; }
    }
    const int vt = tid >> 3, vc2 = tid & 7;
    const bf16_t* vp = (const bf16_t*)(ws + WS_GV) + (tok0 + vt) * 512 + 128 * h + 16 * vc2;
    const u32x4 vw0 = *(const u32x4*)vp, vw1 = *(const u32x4*)(vp + 8);
    if (tid < 256) *(f32x4*)(GR + (tid >> 2) * 16 + 4 * (tid & 3)) = grv;
    lds_barrier();
    {
        float w2[16];
        const float* W2L = (const float*)(lds + G_W2);
#pragma unroll
        for (int r = 0; r < 16; ++r) w2[r] = W2L[r * 64 + d];
        const float bias = W2L[1024 + d];
        float run = 0.f;
#pragma unroll
        for (int tt = 0; tt < 8; ++tt) {
            const float* gr = GR + (8 * tg + tt) * 16;
            float lg = bias;
#pragma unroll
            for (int r4 = 0; r4 < 4; ++r4) { const f32x4 gv = *(const f32x4*)(gr + 4 * r4); lg += gv[0] * w2[4 * r4] + gv[1] * w2[4 * r4 + 1] + gv[2] * w2[4 * r4 + 2] + gv[3] * w2[4 * r4 + 3]; }
            const float lf = (fminf(lg, 0.f) - __logf(1.f + __expf(-fabsf(lg)))) * 0.0625f;
            run += lf; c[tt] = run;
        }
        TOT[tg * 64 + d] = run;
    }
    {
        const int t = vt, c2 = vc2;
        const unsigned ww[8] = {vw0.x, vw0.y, vw0.z, vw0.w, vw1.x, vw1.y, vw1.z, vw1.w};
#pragma unroll
        for (int e = 0; e < 8; ++e) { VT[(16 * c2 + 2 * e) * 72 + t] = (bf16_t)(ww[e] & 0xffffu); VT[(16 * c2 + 2 * e + 1) * 72 + t] = (bf16_t)(ww[e] >> 16); }
    }
    lds_barrier();
    {
        float pre = 0.f, Bl = 0.f;
#pragma unroll
        for (int g = 0; g < 8; ++g) { const float tv = TOT[g * 64 + d]; if (g < tg) pre += tv; Bl += tv; }
        bf16_t* qt = (bf16_t*)(ws + WS_GQT) + (size_t)task * 4096;
        float kd[8];
#pragma unroll
        for (int tt = 0; tt < 8; ++tt) {
            const float Bv = c[tt] + pre; const int t = 8 * tg + tt;
            const float Rh = 0.5f * Bl;
            const float qv = h1f(qraw[tt]) * 0.125f * __expf(fminf(fmaxf(Bv - Rh, -9.5f), 9.5f)), kv = h1f(kraw[tt]);
            const bf16_t qb = (bf16_t)f2bf(qv);
            QS[t * 72 + d] = qb; qt[t * 64 + d] = qb;
            KS[t * 72 + d] = (bf16_t)f2bf(kv * __expf(fmaxf(fminf(Rh - Bv, 9.5f), -9.5f)));
            kd[tt] = kv * __expf(Bl - Bv);
        }
        u32x4 w; w.x = pk2(kd[0], kd[1]); w.y = pk2(kd[2], kd[3]); w.z = pk2(kd[4], kd[5]); w.w = pk2(kd[6], kd[7]);
        *(u32x4*)(KDT + d * 72 + 8 * tg) = w;
        if (tg == 0) ((float*)(ws + WS_EBL))[(size_t)task * 64 + d] = expf(Bl);
    }
    lds_barrier();
    {
        bf16_t* vt = (bf16_t*)(ws + WS_GVT) + (size_t)task * 8192;
        for (int idx = tid; idx < 1024; idx += 512) { const int row = idx >> 3, ch = idx & 7; *(u32x4*)(vt + row * 64 + 8 * ch) = *(const u32x4*)(VT + row * 72 + 8 * ch); }
    }
    {
        bf16_t* att = (bf16_t*)(ws + WS_GATT) + (size_t)task * 4096;
#pragma unroll
        for (int tt = 0; tt < 2; ++tt) {
            const int tile = 2 * wave + tt, Tj = tile >> 2, Ti = tile & 3;
            f32x4 acc = {0.f, 0.f, 0.f, 0.f};
            if (Ti >= Tj) {
#pragma unroll
                for (int ks = 0; ks < 2; ++ks) {
                    const bf16x8 av = *(const bf16x8*)(KS + (16 * Tj + m) * 72 + 32 * ks + 8 * q), bv = *(const bf16x8*)(QS + (16 * Ti + m) * 72 + 32 * ks + 8 * q);
                    acc = mfma16(av, bv, acc);
                }
            }
            const int i = 16 * Ti + m; float v[4];
#pragma unroll
            for (int r = 0; r < 4; ++r) { const int j = 16 * Tj + 4 * q + r; v[r] = (i >= j) ? acc[r] : 0.f; }
            u32x2 w; w.x = pk2(v[0], v[1]); w.y = pk2(v[2], v[3]);
            *(u32x2*)(att + i * 64 + 16 * Tj + 4 * q) = w;
        }
    }
    {
        bf16_t* st = (bf16_t*)(ws + WS_GST) + (size_t)task * 8192;
#pragma unroll
        for (int Tk = 0; Tk < 4; ++Tk) {
            f32x4 acc = {0.f, 0.f, 0.f, 0.f};
#pragma unroll
            for (int s = 0; s < 2; ++s) {
                const bf16x8 av = *(const bf16x8*)(KDT + (16 * Tk + m) * 72 + 32 * s + 8 * q), bv = *(const bf16x8*)(VT + (16 * wave + m) * 72 + 32 * s + 8 * q);
                acc = mfma16(av, bv, acc);
            }
            u32x2 w; w.x = pk2(acc[0], acc[1]); w.y = pk2(acc[2], acc[3]);
            *(u32x2*)(st + (16 * wave + m) * 64 + 16 * Tk + 4 * q) = w;
        }
    }
    lds_barrier();
}

constexpr int SC_NW = 0, SC_KD = 17408, SC_BUF = 35840;
struct ScanSet { u32x4 pw[2], pk[2], pu[2]; };
__device__ __forceinline__ void scan_load(unsigned char* ws, size_t task, int tid, int w, int m, int q, ScanSet& s) {
    const bf16_t* negW = (const bf16_t*)(ws + WS_NEGW) + task * 8192; const bf16_t* kdT = (const bf16_t*)(ws + WS_KDT) + task * 8192; const bf16_t* uT = (const bf16_t*)(ws + WS_UT) + task * 8192;
#pragma unroll
    for (int i = 0; i < 2; ++i) { const int idx = tid + 512 * i; s.pw[i] = *(const u32x4*)(negW + idx * 8); s.pk[i] = *(const u32x4*)(kdT + idx * 8); s.pu[i] = *(const u32x4*)(uT + (16 * w + m) * 64 + 32 * i + 8 * q); }
}
__device__ __forceinline__ void scan_stage(unsigned char* buf, int tid, const ScanSet& s) {
#pragma unroll
    for (int i = 0; i < 2; ++i) { const int idx = tid + 512 * i;
        *(u32x4*)(buf + SC_NW + ((idx >> 4) * 136 + (((idx & 15) ^ (((idx >> 8) & 1) << 2)) * 8)) * 2) = s.pw[i];
        *(u32x4*)(buf + SC_KD + ((idx >> 3) * 72 + (((idx & 7) ^ (((idx >> 7) & 1) << 2)) * 8)) * 2) = s.pk[i]; }
}
__device__ __forceinline__ void dn_scan(const Args& a, int bh, int half, unsigned char* lds) {
    const int tid = otid(), lane = tid & 63, wv = __builtin_amdgcn_readfirstlane(tid >> 6), w = 4 * half + (wv & 3), m = lane & 15, q = lane >> 4;
    const bool active = wv < 4;
    unsigned char* ws = a.ws;
    f32x4 S[8];
#pragma unroll
    for (int i = 0; i < 8; ++i) S[i] = (f32x4){0.f, 0.f, 0.f, 0.f};
    const float eglv = ((const float*)(ws + WS_EGL))[(size_t)bh * 32 + (lane & 31)];
    ScanSet A, B; u32x4 cu0, cu1;
    { ScanSet t0; scan_load(ws, (size_t)bh * 32, tid, w, m, q, t0); scan_load(ws, (size_t)bh * 32 + 1, tid, w, m, q, B); scan_stage(lds, tid, t0); cu0 = t0.pu[0]; cu1 = t0.pu[1]; }
    __syncthreads();
#define SCAN_STEP(n, ISSUE, STAGE) do { \
        const size_t task = (size_t)bh * 32 + (n); \
        unsigned char* buf = lds + ((n) & 1) * SC_BUF; \
        const bf16_t* NW = (const bf16_t*)(buf + SC_NW); const bf16_t* KD = (const bf16_t*)(buf + SC_KD); \
        bf16_t* uT = (bf16_t*)(ws + WS_UT) + task * 8192; bf16_t* ST = (bf16_t*)(ws + WS_DNST) + task * 16384; \
        const float egl = __shfl(eglv, (n)); \
        if ((n) + 2 < 32) scan_load(ws, task + 2, tid, w, m, q, ISSUE); \
        if (active) { \
        bf16x8 Sb[4], Vb[2]; \
        _Pragma("unroll") for (int ks = 0; ks < 4; ++ks) { Sb[ks] = pack8(S[2 * ks], S[2 * ks + 1]); *(bf16x8*)(ST + (16 * w + m) * 128 + 32 * ks + 8 * q) = Sb[ks]; } \
        bf16x8 fa[8], fb[8]; \
        _Pragma("unroll") for (int i = 0; i < 8; ++i) { const int ks = i >> 1, t = i & 1; fa[i] = *(const bf16x8*)(NW + il(t, m) * 136 + ((4 * ks + q) ^ ((m >> 3) << 2)) * 8); } \
        SCHED_FENCE(); \
        f32x4 v0 = {bflo(cu0.x), bfhi(cu0.x), bflo(cu0.y), bfhi(cu0.y)}, v1 = {bflo(cu0.z), bfhi(cu0.z), bflo(cu0.w), bfhi(cu0.w)}; \
        _Pragma("unroll") for (int ks = 0; ks < 4; ++ks) { v0 = mfma16(fa[2 * ks], Sb[ks], v0); v1 = mfma16(fa[2 * ks + 1], Sb[ks], v1); } \
        _Pragma("unroll") for (int i = 0; i < 8; ++i) { const int ks = i >> 1, t = i & 1; fb[i] = *(const bf16x8*)(NW + (32 + il(t, m)) * 136 + ((4 * ks + q) ^ ((m >> 3) << 2)) * 8); } \
        SCHED_FENCE(); \
        Vb[0] = pack8(v0, v1); \
        *(bf16x8*)(uT + (16 * w + m) * 64 + 8 * q) = Vb[0]; \
        v0 = (f32x4){bflo(cu1.x), bfhi(cu1.x), bflo(cu1.y), bfhi(cu1.y)}; v1 = (f32x4){bflo(cu1.z), bfhi(cu1.z), bflo(cu1.w), bfhi(cu1.w)}; \
        _Pragma("unroll") for (int ks = 0; ks < 4; ++ks) { v0 = mfma16(fb[2 * ks], Sb[ks], v0); v1 = mfma16(fb[2 * ks + 1], Sb[ks], v1); } \
        _Pragma("unroll") for (int i = 0; i < 8; ++i) { const int Pd = i >> 2, t = (i >> 1) & 1, s = i & 1; fa[i] = *(const bf16x8*)(KD + (32 * Pd + il(t, m)) * 72 + ((4 * s + q) ^ ((m >> 3) << 2)) * 8); } \
        SCHED_FENCE(); \
        Vb[1] = pack8(v0, v1); \
        *(bf16x8*)(uT + (16 * w + m) * 64 + 32 + 8 * q) = Vb[1]; \
        _Pragma("unroll") for (int i = 0; i < 8; i += 2) { const int Pd = i >> 2, t = (i >> 1) & 1; \
            f32x4 acc = S[2 * Pd + t] * egl; acc = mfma16(fa[i], Vb[0], acc); acc = mfma16(fa[i + 1], Vb[1], acc); S[2 * Pd + t] = acc; } \
        _Pragma("unroll") for (int i = 0; i < 8; ++i) { const int Pd = 2 + (i >> 2), t = (i >> 1) & 1, s = i & 1; fb[i] = *(const bf16x8*)(KD + (32 * Pd + il(t, m)) * 72 + ((4 * s + q) ^ ((m >> 3) << 2)) * 8); } \
        SCHED_FENCE(); \
        _Pragma("unroll") for (int i = 0; i < 8; i += 2) { const int Pd = 2 + (i >> 2), t = (i >> 1) & 1; \
            f32x4 acc = S[2 * Pd + t] * egl; acc = mfma16(fb[i], Vb[0], acc); acc = mfma16(fb[i + 1], Vb[1], acc); S[2 * Pd + t] = acc; } \
        SCHED_FENCE(); } \
        if ((n) + 1 < 32) { scan_stage(lds + (((n) + 1) & 1) * SC_BUF, tid, STAGE); cu0 = STAGE.pu[0]; cu1 = STAGE.pu[1]; } \
        lds_barrier(); } while (0)
#pragma unroll 1
    for (int n = 0; n < 32; n += 2) { SCAN_STEP(n, A, B); SCAN_STEP(n + 1, B, A); }
#undef SCAN_STEP
}
__device__ __forceinline__ void gla_prefix(const Args& a, int vb, int nvb) {
    unsigned char* ws = a.ws;
    for (int item = vb * 512 + otid(); item < 32768; item += nvb * 512) {
        const int bh = item >> 10, dv = (item >> 3) & 127, kg = item & 7;
        float S[8];
#pragma unroll
        for (int e = 0; e < 8; ++e) S[e] = 0.f;
        for (int n0 = 0; n0 < 32; n0 += 8) {
            u32x4 dw[8]; f32x4 e0[8], e1[8];
#pragma unroll
            for (int j = 0; j < 8; ++j) {
                const size_t task = (size_t)bh * 32 + n0 + j;
                dw[j] = *(const u32x4*)((const bf16_t*)(ws + WS_GST) + task * 8192 + dv * 64 + 8 * kg);
                const float* eb = (const float*)(ws + WS_EBL) + task * 64 + 8 * kg;
                e0[j] = *(const f32x4*)eb; e1[j] = *(const f32x4*)(eb + 4);
            }
#pragma unroll
            for (int j = 0; j < 8; ++j) {
                const size_t task = (size_t)bh * 32 + n0 + j;
                const f32x4 r0 = {sqrtf(e0[j][0]), sqrtf(e0[j][1]), sqrtf(e0[j][2]), sqrtf(e0[j][3])}, r1 = {sqrtf(e1[j][0]), sqrtf(e1[j][1]), sqrtf(e1[j][2]), sqrtf(e1[j][3])};
                u32x4 o; o.x = pk2(S[0] * r0[0], S[1] * r0[1]); o.y = pk2(S[2] * r0[2], S[3] * r0[3]); o.z = pk2(S[4] * r1[0], S[5] * r1[1]); o.w = pk2(S[6] * r1[2], S[7] * r1[3]);
                *(u32x4*)((bf16_t*)(ws + WS_GST) + task * 8192 + dv * 64 + 8 * kg) = o;
                float dS[8]; unpack8(dw[j], dS);
                S[0] = S[0] * e0[j][0] + dS[0]; S[1] = S[1] * e0[j][1] + dS[1]; S[2] = S[2] * e0[j][2] + dS[2]; S[3] = S[3] * e0[j][3] + dS[3];
                S[4] = S[4] * e1[j][0] + dS[4]; S[5] = S[5] * e1[j][1] + dS[5]; S[6] = S[6] * e1[j][2] + dS[6]; S[7] = S[7] * e1[j][3] + dS[7];
            }
        }
    }
}

template <int DK>
__device__ __forceinline__ void out_phase(const Args& a, int l, bool gla, int first, int stride, unsigned char* lds) {
    const int tid = otid(), lane = tid & 63, w = __builtin_amdgcn_readfirstlane(tid >> 6), m = lane & 15, q = lane >> 4;
    unsigned char* ws = a.ws;
    constexpr int QP = DK + 8, NQ = 64 * DK / 8 / 512;
    constexpr int B_AT = 64 * QP * 2, B_SZ = B_AT + 64 * 72 * 2, O_RED = 2 * B_SZ;
    const float oscale = gla ? 1.f : (1.f / 128.f);
    const bf16_t* STb = (const bf16_t*)(ws + (gla ? WS_GST : WS_DNST)); const bf16_t* QTb = (const bf16_t*)(ws + (gla ? WS_GQT : WS_DQT));
    const bf16_t* VTb = (const bf16_t*)(ws + (gla ? WS_GVT : WS_UT)); const bf16_t* ATb = (const bf16_t*)(ws + (gla ? WS_GATT : WS_DATT));
    const bf16_t* Z = (const bf16_t*)(ws + (gla ? WS_GZ : WS_DNZ));
    bf16_t* O = (bf16_t*)(ws + WS_O);
    const f32x4 gv = *(const f32x4*)((gla ? a.gla_g : a.dn_g) + l * 128 + 16 * w + 4 * q);
    u32x4 pq[NQ], pa, pS[DK / 32], pV[2]; u32x2 pz[4];
    if (first >= NTASK) return;
#define OUT_LOAD(task) do { const size_t _t = (size_t)(task); const int _bh = (task) >> 5, _n = (task) & 31; const size_t _tok0 = (size_t)(_bh >> 2) * SEQ + 64 * _n; \
        _Pragma("unroll") for (int i = 0; i < NQ; ++i) pq[i] = *(const u32x4*)(QTb + _t * (64 * DK) + (tid + 512 * i) * 8); \
        pa = *(const u32x4*)(ATb + _t * 4096 + tid * 8); \
        _Pragma("unroll") for (int ks = 0; ks < DK / 32; ++ks) pS[ks] = *(const u32x4*)(STb + _t * (128 * DK) + (16 * w + m) * DK + 32 * ks + 8 * q); \
        _Pragma("unroll") for (int s = 0; s < 2; ++s) pV[s] = *(const u32x4*)(VTb + _t * 8192 + (16 * w + m) * 64 + 32 * s + 8 * q); \
        _Pragma("unroll") for (int Ti = 0; Ti < 4; ++Ti) pz[Ti] = *(const u32x2*)(Z + (_tok0 + 16 * Ti + m) * 512 + 128 * (_bh & 3) + 16 * w + 4 * q); } while (0)
#define OUT_STAGE(buf) do { unsigned char* _b = lds + (buf) * B_SZ; \
        _Pragma("unroll") for (int i = 0; i < NQ; ++i) { const int idx = tid + 512 * i; *(u32x4*)(_b + ((idx / (DK / 8)) * QP + (idx % (DK / 8)) * 8) * 2) = pq[i]; } \
        *(u32x4*)(_b + B_AT + ((tid >> 3) * 72 + (tid & 7) * 8) * 2) = pa; } while (0)
    OUT_LOAD(first);
    OUT_STAGE(0);
    __syncthreads();
    int it = 0;
    for (int task = first; task < NTASK; task += stride, ++it) {
        const int bh = task >> 5, n = task & 31, h = bh & 3;
        const size_t tok0 = (size_t)(bh >> 2) * SEQ + 64 * n;
        u32x4 cS[DK / 32], cV[2]; u32x2 cz[4];
#pragma unroll
        for (int ks = 0; ks < DK / 32; ++ks) cS[ks] = pS[ks];
        cV[0] = pV[0]; cV[1] = pV[1];
#pragma unroll
        for (int Ti = 0; Ti < 4; ++Ti) cz[Ti] = pz[Ti];
        const bool more = task + stride < NTASK;
        if (more) OUT_LOAD(task + stride);
        const bf16_t* QS = (const bf16_t*)(lds + (it & 1) * B_SZ); const bf16_t* AS = (const bf16_t*)(lds + (it & 1) * B_SZ + B_AT);
        float* red = (float*)(lds + O_RED) + (it & 1) * 512;
        f32x4 acc[4];
#pragma unroll
        for (int Ti = 0; Ti < 4; ++Ti) acc[Ti] = (f32x4){0.f, 0.f, 0.f, 0.f};
#pragma unroll
        for (int ks = 0; ks < DK / 32; ks += 2) {
            bf16x8 fb[8];
#pragma unroll
            for (int i = 0; i < 8; ++i) fb[i] = *(const bf16x8*)(QS + (16 * (i & 3) + m) * QP + 32 * (ks + (i >> 2)) + 8 * q);
            SCHED_FENCE();
#pragma unroll
            for (int i = 0; i < 8; ++i) acc[i & 3] = mfma16(__builtin_bit_cast(bf16x8, cS[ks + (i >> 2)]), fb[i], acc[i & 3]);
            SCHED_FENCE();
        }
        {
            bf16x8 fb[8];
#pragma unroll
            for (int i = 0; i < 8; ++i) fb[i] = *(const bf16x8*)(AS + (16 * (i & 3) + m) * 72 + 32 * (i >> 2) + 8 * q);
            SCHED_FENCE();
#pragma unroll
            for (int i = 0; i < 8; ++i) acc[i & 3] = mfma16(__builtin_bit_cast(bf16x8, cV[i >> 2]), fb[i], acc[i & 3]);
            SCHED_FENCE();
        }
#pragma unroll
        for (int Ti = 0; Ti < 4; ++Ti) {
            acc[Ti] = acc[Ti] * oscale;
            float ss = acc[Ti][0] * acc[Ti][0] + acc[Ti][1] * acc[Ti][1] + acc[Ti][2] * acc[Ti][2] + acc[Ti][3] * acc[Ti][3];
            ss += __shfl_xor(ss, 16); ss += __shfl_xor(ss, 32);
            if (q == 0) red[w * 64 + 16 * Ti + m] = ss;
        }
        if (more) OUT_STAGE((it + 1) & 1);
        lds_barrier();
#pragma unroll
        for (int Ti = 0; Ti < 4; ++Ti) {
            const int t = 16 * Ti + m;
            float tot = 0.f;
#pragma unroll
            for (int ww = 0; ww < 8; ++ww) tot += red[ww * 64 + t];
            const float rstd = rsqrtf(tot * (1.f / 128.f) + EPS);
            const float z0 = hlo(cz[Ti].x), z1 = hhi(cz[Ti].x), z2 = hlo(cz[Ti].y), z3 = hhi(cz[Ti].y);
            u32x2 o; o.x = pkh2(acc[Ti][0] * rstd * gv[0] * siluf(z0), acc[Ti][1] * rstd * gv[1] * siluf(z1));
            o.y = pkh2(acc[Ti][2] * rstd * gv[2] * siluf(z2), acc[Ti][3] * rstd * gv[3] * siluf(z3));
            *(u32x2*)(O + (tok0 + t) * 1024 + (gla ? 512 : 0) + 128 * h + 16 * w + 4 * q) = o;
        }
    }
    __syncthreads();
#undef OUT_LOAD
#undef OUT_STAGE
}

constexpr int LDS_BYTES = 152064 + 6144 + 16;
__global__ void __launch_bounds__(512, 2) mk_fwd(Args a) {
    extern __shared__ __attribute__((aligned(16))) unsigned char lds[];
    cg::grid_group grid = cg::this_grid();
    const int G = gridDim.x, bid = blockIdx.x;
    int ph = 0;
#define PHASE_BEGIN if (ph >= a.ph_lo && ph < a.ph_hi) {
#define PHASE_END   if (ph + 1 < a.ph_hi) { \
        xcd_barrier(xbar); } \
    } ++ph;
    volatile LAS unsigned* bst = (volatile LAS unsigned*)((LAS unsigned char*)lds + LDS_BYTES - 16);
    if (threadIdx.x < 4) bst[threadIdx.x] = 0u;
    __syncthreads();
    const XcdBarrier xbar = xcd_barrier_post((unsigned*)(a.ws + WS_BAR), bst);
    if (a.ph_hi > 4096) grid.sync();
    PHASE_BEGIN prologue(a, lds); PHASE_END
    for (int l = 0; l < 2; ++l) {
        const float* resid = l == 0 ? a.x : a.out;
        PHASE_BEGIN {
            pg8::Gemm g{(const bf16_t*)(a.ws + WS_XB), (const bf16_t*)(a.ws + WS_WIN + l * WIN_BYTES), MROWS, NPROJ, DM};
            pg8::StaticOrder S; S.init(MROWS, NPROJ, G, bid); EpiProj E{a.ws};
            pg8::gemm_phase<EpiProj>((LAS unsigned char*)lds, g, S, E);
        } PHASE_END
        PHASE_BEGIN
            { DnPre P; if (bid < NTASK) dn_preload(a, bid, otid(), P);
              int hs = -1; float dtb = 0.f, nexpa = 0.f;
              for (int t = bid; t < NTASK; t += G) {
                  const int h = (t >> 5) & 3;
                  if (h != hs) {
                      const int tt = otid();
                      if (tt < 384) { const int X = tt >> 7, r = tt & 127, tap = r >> 5, c4 = r & 31;
                          const float sc = X < 2 ? (1.f / 4096.f) : 1.f;
                          *(f32x4*)((float*)(lds + L_CW) + X * 512 + tap * 128 + 4 * c4) = *(const f32x4*)(a.conv_w + (size_t)l * 4 * 1536 + tap * 1536 + X * 512 + 128 * h + 4 * c4) * sc; }
                      dtb = a.dt_bias[l * 4 + h]; nexpa = -__expf(a.a_log[l * 4 + h]);
                      hs = h; lds_barrier();
                  }
                  dn_prep(a, l, t, t + G < NTASK ? t + G : -1, P, dtb, nexpa, lds);
              } }
            { int hs = -1;
              for (int t = bid; t < NTASK; t += G) {
                  const int h = (t >> 5) & 3;
                  if (h != hs) {
                      const int tt = otid(); float* W2L = (float*)(lds + G_W2);
                      for (int i = tt; i < 1088; i += 512) W2L[i] = i < 1024 ? a.gw2[(size_t)l * 16 * 256 + (i >> 6) * 256 + 64 * h + (i & 63)] : a.gb[l * 256 + 64 * h + (i - 1024)];
                      hs = h; lds_barrier();
                  }
                  gla_prep(a, l, t, lds);
              } }
        PHASE_END
        PHASE_BEGIN
            if (bid < 64) dn_scan(a, (bid & 7) + 8 * (bid >> 4), (bid >> 3) & 1, lds);
            else {
                unsigned* cnt = (unsigned*)(a.ws + WS_CNT) + 64 * l;
                const int vb = bid - 64, nvb = G - 64, nprod = nvb < 64 ? nvb : 64;
                gla_prefix(a, vb, nvb);
                asm volatile("s_waitcnt vmcnt(0)" ::: "memory");
                __syncthreads();
                if (threadIdx.x == 0) {
                    if (vb < nprod) { __builtin_amdgcn_fence(__ATOMIC_RELEASE, "agent"); asm volatile("s_waitcnt vmcnt(0)" ::: "memory"); (void)xb_add(cnt, 1u); }
                    unsigned sp = 0;
                    while (xb_ld(cnt) < (unsigned)nprod) { __builtin_amdgcn_s_sleep(4); if (++sp > (1u << 24)) break; }
                    __builtin_amdgcn_fence(__ATOMIC_ACQUIRE, "agent"); asm volatile("s_waitcnt vmcnt(0)" ::: "memory");
                }
                __syncthreads();
                out_phase<64>(a, l, true, vb, nvb, lds);
                if (l == 0) { const int tt = otid(); convert_weights(a, 1, vb * 8 + (tt >> 6), nvb * 8, (float*)(lds + (tt >> 6) * 8448), tt & 63); }
            }
        PHASE_END
        PHASE_BEGIN
            out_phase<128>(a, l, false, bid, G, lds);
        PHASE_END
        PHASE_BEGIN {
            pg8::Gemm g{(const bf16_t*)(a.ws + WS_O), (const bf16_t*)(a.ws + WS_WOUT + l * WOUT_BYTES), MROWS, DM, DM};
            pg8::StaticOrder S; S.init(MROWS, DM, G, bid);
            EpiOutLN E{resid, a.out, l == 0 ? (bf16_t*)(a.ws + WS_XB) : nullptr, a.ln_g + l * DM, a.ln_b + l * DM, (unsigned*)(a.ws + WS_XBUF), (unsigned*)(a.ws + WS_LNCNT) + l * 4096};
            pg8::gemm_phase<EpiOutLN>((LAS unsigned char*)lds, g, S, E);
        } PHASE_END
    }
}
constexpr int NPHASE = 11;

extern "C" void kernel_launch(void* const* d_in, const int* in_sizes, int n_in, void* d_out, int out_size,
                              void* d_ws, size_t ws_size, hipStream_t stream) {
    static int grid = 0;
    if (grid == 0) {
        int dev = 0, cus = 0, per_cu = 0;
        (void)hipGetDevice(&dev);
        (void)hipDeviceGetAttribute(&cus, hipDeviceAttributeMultiprocessorCount, dev);
        (void)hipFuncSetAttribute((const void*)mk_fwd, hipFuncAttributeMaxDynamicSharedMemorySize, LDS_BYTES);
        (void)hipOccupancyMaxActiveBlocksPerMultiprocessor(&per_cu, (const void*)mk_fwd, 512, LDS_BYTES);
        if (per_cu < 1) { fprintf(stderr, "kernel_launch: occupancy query reports %d blocks per CU\n", per_cu); }
        grid = cus > 0 ? cus : 256;
        if (ws_size < WS_END) { fprintf(stderr, "kernel_launch: workspace too small: %zu < %zu\n", ws_size, (size_t)WS_END); grid = -1; }
    }
    if (grid < 0) return;
    Args a{};
    a.x = (const float*)d_in[0]; a.w_in = (const float*)d_in[1]; a.conv_w = (const float*)d_in[2]; a.a_log = (const float*)d_in[3];
    a.dt_bias = (const float*)d_in[4]; a.gw2 = (const float*)d_in[5]; a.gb = (const float*)d_in[6]; a.dn_g = (const float*)d_in[7];
    a.gla_g = (const float*)d_in[8]; a.w_out = (const float*)d_in[9]; a.ln_g = (const float*)d_in[10]; a.ln_b = (const float*)d_in[11];
    a.out = (float*)d_out; a.ws = (unsigned char*)d_ws;
#ifndef MK_LAUNCHES
#define MK_LAUNCHES 1
#endif
    (void)hipMemsetAsync((char*)d_ws + WS_BAR, 0, 65536, stream);
    for (int li = 0; li < MK_LAUNCHES; ++li) {
        a.ph_lo = MK_LAUNCHES == 1 ? 0 : li; a.ph_hi = MK_LAUNCHES == 1 ? NPHASE : li + 1;
        void* args[] = {&a};
        hipError_t e = hipLaunchCooperativeKernel((const void*)mk_fwd, dim3(grid), dim3(512), args, LDS_BYTES, stream);
        if (e != hipSuccess) { fprintf(stderr, "cooperative launch failed: %s\n", hipGetErrorString(e)); break; }
    }
}
```
